# Optimizing an MI355X kernel written in HIP

```python
import math
import jax
import jax.numpy as jnp
from jax import lax
import numpy as np

D_MODEL = 1024
BATCH = 16
SEQ = 256
DEPTH = 2
DEC_BATCH = 8
DEC_SEQ = 1024
PAST_LEN = 512

GRID_W = 64
N_BRANCH = 4
BR_W = D_MODEL // 4
HD = 64
A_HEADS = BR_W // HD
A_QK = HD // 2
B_BLOCKS = 4
B_BLK = BR_W // B_BLOCKS
CONV_W = 4
CONV_LEFT = 1
LRU_C = 8.0
C_HEADS = BR_W // HD
NA_ROWS = 8
NA_COLS = 16
NA_QB = 16
NA_KB = NA_QB + NA_COLS
D_HEADS = BR_W // HD
D_KV = 2
D_GROUP = D_HEADS // D_KV
WIN = 128
QBLK = 128
ROPE_BASE = 10000.0
EPS = 1e-6
NEG = -1e30
IN_SIZES = (N_BRANCH * BR_W, 3 * A_HEADS * HD, BR_W, 3 * C_HEADS * HD, D_HEADS * HD, 2 * D_KV * HD)
IN_W = sum(IN_SIZES)
IN_SPLITS = tuple(int(s) for s in np.cumsum(IN_SIZES)[:-1])

kernel_name = 'hybrid_diffusion_prefix_step'


def rmsnorm(x, g):
    xf = x.astype(jnp.float32)
    y = xf * lax.rsqrt(jnp.mean(xf * xf, axis=-1, keepdims=True) + EPS)
    return (y * g.astype(jnp.float32)).astype(x.dtype)


def rope1d(x, pos):
    half = x.shape[-1] // 2
    inv = ROPE_BASE ** (-jnp.arange(half, dtype=jnp.float32) / half)
    ang = pos.astype(jnp.float32)[:, None] * inv[None, :]
    cos, sin = jnp.cos(ang), jnp.sin(ang)
    xf = x.astype(jnp.float32)
    x1, x2 = xf[..., :half], xf[..., half:]
    return jnp.concatenate([x1 * cos - x2 * sin, x1 * sin + x2 * cos], axis=-1).astype(x.dtype)


def rope2d(x):
    t = jnp.arange(x.shape[-2])
    half = x.shape[-1] // 2
    return jnp.concatenate([rope1d(x[..., :half], t // GRID_W), rope1d(x[..., half:], t % GRID_W)], axis=-1)


def heads(x, n):
    b, l, _ = x.shape
    return x.reshape(b, l, n, -1).transpose(0, 2, 1, 3)


def softmax_with_sink(s, sink):
    sk = jnp.broadcast_to(sink.astype(jnp.float32)[None, :, :, None, None], s.shape[:-1] + (1,))
    return jax.nn.softmax(jnp.concatenate([sk, s], axis=-1), axis=-1)[..., 1:]


def diff_attention(q, k, v, lam):
    b, h, _, lq, d = q.shape
    nb = lq // QBLK
    scale = d ** -0.5

    def block(qb):
        s = jnp.einsum('bhmqd,bhmkd->bhmqk', qb, k).astype(jnp.float32) * scale
        p = jax.nn.softmax(s, axis=-1)
        w = p[:, :, 0] - lam * p[:, :, 1]
        return jnp.einsum('bhqk,bhkd->bhqd', w.astype(v.dtype), v)

    qb = q.reshape(b, h, 2, nb, QBLK, d).transpose(3, 0, 1, 2, 4, 5)
    out = lax.map(block, qb)
    return out.transpose(1, 2, 0, 3, 4).reshape(b, h, lq, v.shape[-1])


def attend_dense(q, k, v, sink):
    b, kv, g, lq, d = q.shape
    nb = lq // QBLK
    scale = d ** -0.5

    def block(qb):
        s = jnp.einsum('bkgqd,bkcd->bkgqc', qb, k).astype(jnp.float32) * scale
        p = jax.nn.softmax(s, axis=-1) if sink is None else softmax_with_sink(s, sink)
        return jnp.einsum('bkgqc,bkcd->bkgqd', p.astype(v.dtype), v)

    qb = q.reshape(b, kv, g, nb, QBLK, d).transpose(3, 0, 1, 2, 4, 5)
    out = lax.map(block, qb)
    return out.transpose(1, 2, 3, 0, 4, 5).reshape(b, kv, g, lq, v.shape[-1])


def swa_latent(q, k, v, k_ctx, v_ctx, sink):
    b, kv, g, L, d = q.shape
    nb = L // QBLK
    span = QBLK + 2 * WIN
    scale = d ** -0.5
    n_ctx = k_ctx.shape[2]
    pad = ((0, 0), (0, 0), (WIN, WIN), (0, 0))
    kp, vp = jnp.pad(k, pad), jnp.pad(v, pad)

    def block(xs):
        qb, j = xs
        start = j * QBLK
        kb = lax.dynamic_slice_in_dim(kp, start, span, axis=2)
        vb = lax.dynamic_slice_in_dim(vp, start, span, axis=2)
        qi = start + jnp.arange(QBLK)
        ki = start - WIN + jnp.arange(span)
        ok = (jnp.abs(qi[:, None] - ki[None, :]) <= WIN) & (ki >= 0)[None, :] & (ki < L)[None, :]
        s_loc = jnp.where(ok, jnp.einsum('bkgqd,bkjd->bkgqj', qb, kb).astype(jnp.float32) * scale, NEG)
        s_ctx = jnp.einsum('bkgqd,bkcd->bkgqc', qb, k_ctx).astype(jnp.float32) * scale
        p = softmax_with_sink(jnp.concatenate([s_ctx, s_loc], axis=-1), sink).astype(v.dtype)
        return (jnp.einsum('bkgqc,bkcd->bkgqd', p[..., :n_ctx], v_ctx)
                + jnp.einsum('bkgqj,bkjd->bkgqd', p[..., n_ctx:], vb))

    qb = q.reshape(b, kv, g, nb, QBLK, d).transpose(3, 0, 1, 2, 4, 5)
    out = lax.map(block, (qb, jnp.arange(nb, dtype=jnp.int32)))
    return out.transpose(1, 2, 3, 0, 4, 5).reshape(b, kv, g, L, d)


def na_latent(q, k, v, k_ctx, v_ctx, rpb):
    b, h, L, d = q.shape
    rows = L // GRID_W
    wr = min(NA_ROWS, rows)
    ncb = GRID_W // NA_QB
    scale = d ** -0.5
    n_ctx = k_ctx.shape[2]
    row_start = np.clip(np.arange(rows) - wr // 2, 0, rows - wr)
    qcols = np.arange(GRID_W).reshape(ncb, NA_QB)
    col_start = np.clip(qcols - NA_COLS // 2, 0, GRID_W - NA_COLS)
    band = (np.clip(np.arange(ncb) * NA_QB - NA_COLS // 2, 0, GRID_W - NA_KB)[:, None]
            + np.arange(NA_KB)[None, :])
    col_ok = (band[:, None, :] >= col_start[:, :, None]) & (band[:, None, :] < col_start[:, :, None] + NA_COLS)
    dcol = np.clip(band[:, None, :] - qcols[:, :, None] + NA_COLS - 1, 0, 2 * NA_COLS - 2)
    kg = k.reshape(b, h, rows, GRID_W, d)
    vg = v.reshape(b, h, rows, GRID_W, d)
    rpbf = rpb.astype(jnp.float32)

    def row_block(xs):
        qr, rs, ri = xs
        kb = lax.dynamic_slice_in_dim(kg, rs, wr, axis=2)[:, :, :, band]
        vb = lax.dynamic_slice_in_dim(vg, rs, wr, axis=2)[:, :, :, band]
        s_loc = jnp.einsum('bhnqd,bhrnkd->bhnqrk', qr, kb).astype(jnp.float32) * scale
        drow = rs + jnp.arange(wr) - ri + NA_ROWS - 1
        bias = rpbf[:, drow[:, None, None, None], dcol[None]].transpose(0, 2, 3, 1, 4)
        s_loc = jnp.where(col_ok[:, :, None, :], s_loc + bias, NEG).reshape(b, h, ncb, NA_QB, wr * NA_KB)
        s_ctx = jnp.einsum('bhnqd,bhcd->bhnqc', qr, k_ctx).astype(jnp.float32) * scale
        p = jax.nn.softmax(jnp.concatenate([s_ctx, s_loc], axis=-1), axis=-1).astype(v.dtype)
        p_loc = p[..., n_ctx:].reshape(b, h, ncb, NA_QB, wr, NA_KB)
        return (jnp.einsum('bhnqc,bhcd->bhnqd', p[..., :n_ctx], v_ctx)
                + jnp.einsum('bhnqrk,bhrnkd->bhnqd', p_loc, vb))

    qr = q.reshape(b, h, rows, ncb, NA_QB, d).transpose(2, 0, 1, 3, 4, 5)
    out = lax.map(row_block, (qr, jnp.asarray(row_start, jnp.int32), jnp.arange(rows, dtype=jnp.int32)))
    return out.transpose(1, 2, 0, 3, 4, 5).reshape(b, h, L, d)


def conv_centred(x, w, bias):
    L = x.shape[1]
    xp = jnp.pad(x, ((0, 0), (CONV_LEFT, CONV_W - 1 - CONV_LEFT), (0, 0)))
    y = bias
    for j in range(CONV_W):
        y = y + xp[:, j:j + L] * w[j]
    return y


def rglru(x, wa, ba, wx, bx, lam, h0, reverse):
    f32 = jnp.float32
    b, L, W = x.shape
    xf = x.astype(f32)
    xb = xf.reshape(b, L, B_BLOCKS, B_BLK)
    r = jax.nn.sigmoid(jnp.einsum('blnj,njk->blnk', xb, wa.astype(f32)).reshape(b, L, W) + ba.astype(f32))
    i = jax.nn.sigmoid(jnp.einsum('blnj,njk->blnk', xb, wx.astype(f32)).reshape(b, L, W) + bx.astype(f32))
    log_a = -LRU_C * r * jax.nn.softplus(-lam.astype(f32))
    a = jnp.exp(log_a)
    u = jnp.sqrt(-jnp.expm1(2.0 * log_a)) * (i * xf)

    def step(hc, au):
        hc = au[0] * hc + au[1]
        return hc, hc

    h_last, hs = lax.scan(step, h0.astype(f32), (a.swapaxes(0, 1), u.swapaxes(0, 1)), reverse=reverse)
    return hs.swapaxes(0, 1), h_last


def merge_out(h, br, gates, w_mg, b_mg, w_bo, w_o):
    g = jax.nn.sigmoid(jnp.einsum('bld,dnm->blnm', h, w_mg) + b_mg)
    proj = jnp.einsum('blnw,nwm->blnm', br * jax.nn.silu(gates), w_bo)
    return jnp.einsum('blnm,blnm->blm', g, proj) @ w_o


def layer(x, cvec, lp, l, cache):
    (norm_g, w_ada, b_ada, w_in, diff_lam, diff_g, conv_w, conv_b, lru_wa, lru_ba, lru_wx, lru_bx,
     lru_lam, na_rpb, swa_sink, w_mg, b_mg, w_bo, w_o) = lp
    f32 = jnp.float32
    b, L, _ = x.shape
    mod = (jax.nn.silu(cvec) @ w_ada + b_ada)[:, None, :]
    shift, scale, gate = jnp.split(mod, 3, axis=-1)
    h = rmsnorm(x, norm_g) * (1.0 + scale) + shift
    g_br, a_qkv, b_x, c_qkv, d_q, d_kv = jnp.split(h @ w_in, IN_SPLITS, axis=-1)

    aq, ak, av = jnp.split(a_qkv, 3, axis=-1)
    aq = aq.reshape(b, L, A_HEADS, 2, A_QK).transpose(0, 2, 3, 1, 4)
    ak = ak.reshape(b, L, A_HEADS, 2, A_QK).transpose(0, 2, 3, 1, 4)
    av = heads(av, A_HEADS)
    lam_init = 0.8 - 0.6 * math.exp(-0.3 * l)
    lf = diff_lam.astype(f32)
    lam = jnp.exp(jnp.sum(lf[0] * lf[1])) - jnp.exp(jnp.sum(lf[2] * lf[3])) + lam_init

    cq, ck, cv = [heads(t, C_HEADS) for t in jnp.split(c_qkv, 3, axis=-1)]
    dq = d_q.reshape(b, L, D_KV, D_GROUP, HD).transpose(0, 2, 3, 1, 4)
    dk, dv = [heads(t, D_KV) for t in jnp.split(d_kv, 2, axis=-1)]
    sink = swa_sink.reshape(D_KV, D_GROUP)
    xc = conv_centred(b_x, conv_w, conv_b)

    if cache is None:
        ya = diff_attention(aq, ak, av, lam)
        h0f = jnp.zeros((b, BR_W), f32)
        h0b = jnp.zeros((b, BR_W), f32)
        yc = attend_dense(cq[:, :, None], ck, cv, None)[:, :, 0]
        yd = attend_dense(dq, dk, dv, sink)
    else:
        ck_a, cv_a, ck_c, cv_c, ck_d, cv_d, st = cache
        ya = diff_attention(rope2d(aq), jnp.concatenate([ck_a, rope2d(ak)], axis=3),
                            jnp.concatenate([cv_a, av], axis=2), lam)
        h0f, h0b = st[:, 0], st[:, 1]
        yc = na_latent(cq, ck, cv, ck_c, cv_c, na_rpb)
        yd = swa_latent(rope2d(dq), rope2d(dk), dv, ck_d, cv_d, sink)

    ya = (rmsnorm(ya, diff_g) * (1.0 - lam_init)).transpose(0, 2, 1, 3).reshape(b, L, BR_W)
    yf, hf = rglru(xc, lru_wa[0], lru_ba[0], lru_wx[0], lru_bx[0], lru_lam[0], h0f, False)
    yb, hb = rglru(xc, lru_wa[1], lru_ba[1], lru_wx[1], lru_bx[1], lru_lam[1], h0b, True)
    yr = (yf + yb).astype(x.dtype)
    yc = yc.transpose(0, 2, 1, 3).reshape(b, L, BR_W)
    yd = yd.transpose(0, 3, 1, 2, 4).reshape(b, L, BR_W)
    br = jnp.stack([ya, yr, yc, yd], axis=2)
    out = merge_out(h, br, g_br.reshape(b, L, N_BRANCH, BR_W), w_mg, b_mg, w_bo, w_o)
    x = x + gate * out
    if cache is None:
        return x, (ak, av, ck, cv, dk, dv, jnp.stack([hf, hb], axis=1).astype(x.dtype))
    return x, None


def setup_inputs(seed: int = 0) -> dict:
    key = jax.random.key(seed)
    ks = list(jax.random.split(key, 32))
    f32 = jnp.float32

    def nrm(i, shape, s):
        return jax.random.normal(ks[i], shape, f32) * s

    a0 = jax.random.uniform(ks[31], (DEPTH, 2, BR_W), f32, 0.9, 0.999)
    return {
        'x_prompt': nrm(0, (BATCH, SEQ, D_MODEL), 1.0),
        'x_sample': nrm(1, (DEC_BATCH, DEC_SEQ, D_MODEL), 1.0),
        'cache_diff_k': nrm(2, (DEC_BATCH, DEPTH, A_HEADS, 2, PAST_LEN, A_QK), 1.0),
        'cache_diff_v': nrm(3, (DEC_BATCH, DEPTH, A_HEADS, PAST_LEN, HD), 1.0),
        'cache_na_k': nrm(4, (DEC_BATCH, DEPTH, C_HEADS, PAST_LEN, HD), 1.0),
        'cache_na_v': nrm(5, (DEC_BATCH, DEPTH, C_HEADS, PAST_LEN, HD), 1.0),
        'cache_swa_k': nrm(6, (DEC_BATCH, DEPTH, D_KV, PAST_LEN, HD), 1.0),
        'cache_swa_v': nrm(7, (DEC_BATCH, DEPTH, D_KV, PAST_LEN, HD), 1.0),
        'state_lru': nrm(8, (DEC_BATCH, DEPTH, 2, BR_W), 0.5),
        'c': nrm(9, (DEC_BATCH, D_MODEL), 1.0),
        'c_ctx': nrm(10, (D_MODEL,), 1.0),
        'norm_g': 1.0 + nrm(11, (DEPTH, D_MODEL), 0.02),
        'w_ada': nrm(12, (DEPTH, D_MODEL, 3 * D_MODEL), 0.5 * D_MODEL ** -0.5),
        'b_ada': nrm(13, (DEPTH, 3 * D_MODEL), 0.02),
        'w_in': nrm(14, (DEPTH, D_MODEL, IN_W), D_MODEL ** -0.5),
        'diff_lambda': nrm(15, (DEPTH, 4, A_QK), 0.1),
        'diff_norm_g': 1.0 + nrm(16, (DEPTH, HD), 0.02),
        'conv_w': nrm(17, (DEPTH, CONV_W, BR_W), CONV_W ** -0.5),
        'conv_b': nrm(18, (DEPTH, BR_W), 0.02),
        'lru_wa': nrm(19, (DEPTH, 2, B_BLOCKS, B_BLK, B_BLK), B_BLK ** -0.5),
        'lru_ba': nrm(20, (DEPTH, 2, BR_W), 0.02),
        'lru_wx': nrm(21, (DEPTH, 2, B_BLOCKS, B_BLK, B_BLK), B_BLK ** -0.5),
        'lru_bx': nrm(22, (DEPTH, 2, BR_W), 0.02),
        'lru_lam': jnp.log(a0) - jnp.log1p(-a0),
        'na_rpb': nrm(23, (DEPTH, C_HEADS, 2 * NA_ROWS - 1, 2 * NA_COLS - 1), 0.1),
        'swa_sink': nrm(24, (DEPTH, D_HEADS), 0.5),
        'w_mg': nrm(25, (DEPTH, D_MODEL, N_BRANCH, D_MODEL), D_MODEL ** -0.5),
        'b_mg': nrm(26, (DEPTH, N_BRANCH, D_MODEL), 0.02),
        'w_bo': nrm(27, (DEPTH, N_BRANCH, BR_W, D_MODEL), BR_W ** -0.5),
        'w_o': nrm(28, (DEPTH, D_MODEL, D_MODEL), D_MODEL ** -0.5),
        'norm_f': 1.0 + nrm(29, (D_MODEL,), 0.02),
    }


def reference(x_prompt, x_sample, cache_diff_k, cache_diff_v, cache_na_k, cache_na_v, cache_swa_k, cache_swa_v,
              state_lru, c, c_ctx, norm_g, w_ada, b_ada, w_in, diff_lambda, diff_norm_g, conv_w, conv_b,
              lru_wa, lru_ba, lru_wx, lru_bx, lru_lam, na_rpb, swa_sink, w_mg, b_mg, w_bo, w_o, norm_f):
    xp = x_prompt
    xs = x_sample
    per_layer = []
    for l in range(DEPTH):
        lp = (norm_g[l], w_ada[l], b_ada[l], w_in[l], diff_lambda[l], diff_norm_g[l], conv_w[l], conv_b[l],
              lru_wa[l], lru_ba[l], lru_wx[l], lru_bx[l], lru_lam[l], na_rpb[l], swa_sink[l],
              w_mg[l], b_mg[l], w_bo[l], w_o[l])
        xp, st = layer(xp, c_ctx[None, :], lp, l, None)
        per_layer.append(st)
        cache_l = (cache_diff_k[:, l], cache_diff_v[:, l], cache_na_k[:, l], cache_na_v[:, l],
                   cache_swa_k[:, l], cache_swa_v[:, l], state_lru[:, l])
        xs, _ = layer(xs, c, lp, l, cache_l)
    y_prompt = rmsnorm(xp, norm_f)
    y_sample = rmsnorm(xs, norm_f)
    stacked = [jnp.stack([per_layer[l][i] for l in range(DEPTH)], axis=1) for i in range(7)]
    new_diff_k, new_diff_v, new_na_k, new_na_v, new_swa_k, new_swa_v, new_state_lru = stacked
    return (y_prompt, y_sample, new_diff_k, new_diff_v, new_na_k, new_na_v, new_swa_k, new_swa_v, new_state_lru)
```

```cpp
#include <hip/hip_runtime.h>
#include <hip/hip_cooperative_groups.h>
#include <cstdio>
#include <cstdint>
namespace cg = cooperative_groups;

typedef __attribute__((ext_vector_type(8))) short bf16x8;
typedef __attribute__((ext_vector_type(4))) float f32x4;
typedef unsigned short bf16_t;

#define T_TOK 12288
#define T_PR 4096
#define INW 3328

struct Params {
  const float *x_prompt, *x_sample, *cdk, *cdv, *cnk, *cnv, *csk, *csv, *state, *c, *c_ctx, *norm_g, *w_ada, *b_ada,
      *w_in, *dlam, *dg, *conv_w, *conv_b, *lru_wa, *lru_ba, *lru_wx, *lru_bx, *lru_lam, *rpb, *sink, *w_mg, *b_mg,
      *w_bo, *w_o, *norm_f;
  float* out;
  unsigned char* ws;
  int ph_lo, ph_hi;
};

constexpr size_t WS_WIN = 0;
constexpr size_t WS_WMG = WS_WIN + (size_t)2 * 3328 * 1024 * 2;
constexpr size_t WS_WBO = WS_WMG + (size_t)2 * 4096 * 1024 * 2;
constexpr size_t WS_WO = WS_WBO + (size_t)2 * 4 * 1024 * 256 * 2;
constexpr size_t WS_WLRU = WS_WO + (size_t)2 * 1024 * 1024 * 2;
constexpr size_t WS_MOD = WS_WLRU + (size_t)32 * 4096 * 2;
constexpr size_t WS_CVA = WS_MOD + (size_t)2 * 9 * 3072 * 4;
constexpr size_t WS_CVC = WS_CVA + (size_t)64 * 64 * 512 * 2;
constexpr size_t WS_CVD = WS_CVC + (size_t)64 * 64 * 512 * 2;
constexpr size_t WS_TABA = WS_CVD + (size_t)32 * 64 * 512 * 2;
constexpr size_t WS_TABD = WS_TABA + 64 * 8 * 8;
constexpr size_t WS_H = WS_TABD + 64 * 16 * 8;
constexpr size_t WS_HIN = WS_H + (size_t)T_TOK * 1024 * 2;
constexpr size_t WS_AVT = WS_HIN + (size_t)T_TOK * INW * 2;
constexpr size_t WS_CVT = WS_AVT + (size_t)3145728 * 2;
constexpr size_t WS_DVT = WS_CVT + (size_t)3145728 * 2;
constexpr size_t WS_BR = WS_DVT + (size_t)1572864 * 2;
constexpr size_t WS_YF = WS_BR + (size_t)T_TOK * 1024 * 2;
constexpr size_t WS_YB = WS_YF + (size_t)T_TOK * 256 * 4;
constexpr size_t WS_PB = WS_YB + (size_t)T_TOK * 256 * 4;
constexpr size_t WS_HEND = WS_PB + (size_t)T_TOK * 256 * 4;
constexpr size_t WS_END = WS_HEND + 16384;
constexpr size_t WS_MB = WS_HIN;
constexpr size_t WS_BAR = WS_END;
constexpr size_t WS_TOTAL = WS_BAR + 32768;
static_assert(WS_TOTAL <= (size_t)256 * 1024 * 1024, "workspace map exceeds the guaranteed 256 MiB");

constexpr size_t O_Y = 0;
constexpr size_t O_DK = 12582912;
constexpr size_t O_DV = 14680064;
constexpr size_t O_NK = 16777216;
constexpr size_t O_NV = 18874368;
constexpr size_t O_SK = 20971520;
constexpr size_t O_SV = 22020096;
constexpr size_t O_ST = 23068672;

#define LDS_BYTES 53248

__device__ __forceinline__ int tid_opaque() {
  int t = threadIdx.x;
  asm volatile("" : "+v"(t));
  return t;
}
#define TIDX tid_opaque()
__device__ __forceinline__ unsigned pack2(float a, float b) {
  typedef __attribute__((ext_vector_type(2))) __bf16 bf2_t;
  typedef __attribute__((ext_vector_type(2))) float f2_t;
  f2_t v = {a, b};
  bf2_t r = __builtin_convertvector(v, bf2_t);
  return __builtin_bit_cast(unsigned, r);
}
__device__ __forceinline__ bf16_t f2bf(float f) { return (bf16_t)(pack2(f, 0.f) & 0xffffu); }
__device__ __forceinline__ float bf2f(bf16_t h) { return __uint_as_float(((unsigned)h) << 16); }
__device__ __forceinline__ float lo2f(unsigned u) { return __uint_as_float(u << 16); }
__device__ __forceinline__ float hi2f(unsigned u) { return __uint_as_float(u & 0xffff0000u); }
__device__ __forceinline__ float sigmoidf_(float x) { return __builtin_amdgcn_rcpf(1.f + __builtin_amdgcn_exp2f(-1.4426950408889634f * x)); }
__device__ __forceinline__ float siluf_(float x) { return x * __builtin_amdgcn_rcpf(1.f + __builtin_amdgcn_exp2f(-1.4426950408889634f * x)); }
__device__ __forceinline__ float wave_sum(float v) {
#pragma unroll
  for (int o = 32; o >= 1; o >>= 1) v += __shfl_xor(v, o);
  return v;
}
__device__ __forceinline__ float rowmax4(float x) {
  unsigned u = __float_as_uint(x);
  auto r32 = __builtin_amdgcn_permlane32_swap(u, u, false, false);
  const float m = fmaxf(__uint_as_float(r32[0]), __uint_as_float(r32[1]));
  unsigned v = __float_as_uint(m);
  auto r16 = __builtin_amdgcn_permlane16_swap(v, v, false, false);
  return fmaxf(__uint_as_float(r16[0]), __uint_as_float(r16[1]));
}
__device__ __forceinline__ f32x4 mfma16(bf16x8 a, bf16x8 b, f32x4 c) {
  return __builtin_amdgcn_mfma_f32_16x16x32_bf16(a, b, c, 0, 0, 0);
}
__device__ __forceinline__ const float* xrow(const Params& p, int l, int t) {
  if (l == 0) return t < T_PR ? p.x_prompt + (size_t)t * 1024 : p.x_sample + (size_t)(t - T_PR) * 1024;
  return p.out + O_Y + (size_t)t * 1024;
}


#define XB_TMO      128
#define XB_XCNT(j)  (256  + 64 * (j))
#define XB_XSUB(j)  (1280 + 64 * (j))
#define XB_XGEN(j)  (2304 + 64 * (j))
#define XB_TOP      3328
#define XB_TOPGEN   3392
#define XCD_BAR_WORDS 3456
#define XB_JOBCTR(i) (3456 + 16 * (i))
#define BAR_TOTAL_WORDS (3456 + 16 * 160)
#define XB_SPIN_CAP (1u << 22)
#define LAS __attribute__((address_space(3)))
__device__ __forceinline__ unsigned xb_ld(unsigned* p) { return __hip_atomic_load(p, __ATOMIC_RELAXED, __HIP_MEMORY_SCOPE_AGENT); }
__device__ __forceinline__ unsigned xb_add(unsigned* p, unsigned v) { return __hip_atomic_fetch_add(p, v, __ATOMIC_RELAXED, __HIP_MEMORY_SCOPE_AGENT); }
__device__ __forceinline__ unsigned xb_xcc_id() { return (unsigned)__builtin_amdgcn_s_getreg((3 << 11) | 20) & 0xFu; }
#define XB_SPIN(cond, bar) do { unsigned _sp = 0; while (cond) { __builtin_amdgcn_s_sleep(1); \
    if ((++_sp & 255u) == 0u) { if (xb_ld(&(bar)[XB_TMO])) break; if (_sp > XB_SPIN_CAP) { atomicAdd(&(bar)[XB_TMO], 1u); break; } } } } while (0)
struct XcdBarrier { unsigned* bar; unsigned x; volatile LAS unsigned* st; };
__device__ __forceinline__ XcdBarrier xcd_barrier_post(unsigned* bar, volatile LAS unsigned* st) {
  XcdBarrier b; b.bar = bar; b.x = xb_xcc_id(); b.st = st;
  if (threadIdx.x == 0) (void)xb_add(&bar[XB_XCNT(b.x)], 1u);
  return b;
}
__device__ __forceinline__ void xcd_barrier_complete(unsigned* bar, unsigned x, unsigned& nloc, unsigned& nx) {
  const unsigned G = gridDim.x * gridDim.y * gridDim.z;
  unsigned sum, cnt, mine, sp = 0u;
  for (;;) {
    sum = 0u; cnt = 0u; mine = 0u;
#pragma unroll
    for (unsigned j = 0; j < 16; ++j) { const unsigned c = xb_ld(&bar[XB_XCNT(j)]); sum += c; cnt += (c > 0u) ? 1u : 0u; mine = (j == x) ? c : mine; }
    if (sum == G) break;
    __builtin_amdgcn_s_sleep(1);
    if ((++sp & 255u) == 0u) { if (xb_ld(&bar[XB_TMO])) break; if (sp > XB_SPIN_CAP) { atomicAdd(&bar[XB_TMO], 1u); break; } }
  }
  nloc = mine > 0u ? mine : 1u; nx = cnt > 0u ? cnt : 1u;
}
__device__ __forceinline__ void xcd_barrier(const XcdBarrier& b) {
  asm volatile("s_waitcnt vmcnt(0)" ::: "memory");
  __syncthreads();
  if (threadIdx.x == 0) {
    unsigned* bar = b.bar;
    __builtin_amdgcn_s_waitcnt(0);
    unsigned nloc = b.st[0], nx = b.st[1];
    if (nloc == 0u) { xcd_barrier_complete(bar, b.x, nloc, nx); b.st[0] = nloc; b.st[1] = nx; }
    const unsigned old = xb_add(&bar[XB_XSUB(b.x)], 1u);
    const unsigned gen = old / nloc;
    if (old + 1u == (gen + 1u) * nloc) {
      __builtin_amdgcn_fence(__ATOMIC_RELEASE, "agent");
      asm volatile("s_waitcnt vmcnt(0)" ::: "memory");
      const unsigned og = xb_add(&bar[XB_TOP], 1u);
      const unsigned tg = og / nx;
      if (og + 1u == (tg + 1u) * nx) xb_add(&bar[XB_TOPGEN], 1u);
      else XB_SPIN(xb_ld(&bar[XB_TOPGEN]) == tg, bar);
      __builtin_amdgcn_fence(__ATOMIC_ACQUIRE, "agent");
      xb_add(&bar[XB_XGEN(b.x)], 1u);
      asm volatile("s_waitcnt vmcnt(0)" ::: "memory");
    } else {
      XB_SPIN(xb_ld(&bar[XB_XGEN(b.x)]) == gen, bar);
      __builtin_amdgcn_fence(__ATOMIC_ACQUIRE, "agent");
      asm volatile("s_waitcnt vmcnt(0)" ::: "memory");
    }
  }
  __syncthreads();
}

__device__ void transpose_tile(const float* __restrict__ src, int sld, bf16_t* __restrict__ dst, int dld, float* tile) {
  const int tid = TIDX;
  {
    const int r0 = tid >> 4, c4 = (tid & 15) * 4;
#pragma unroll
    for (int i = 0; i < 4; ++i) {
      const int r = r0 + 16 * i;
      const float4 v = *(const float4*)(src + (size_t)r * sld + c4);
      tile[r * 65 + c4 + 0] = v.x;
      tile[r * 65 + c4 + 1] = v.y;
      tile[r * 65 + c4 + 2] = v.z;
      tile[r * 65 + c4 + 3] = v.w;
    }
  }
  __syncthreads();
  {
    const int r8 = (tid & 7) * 8, c0 = tid >> 3;
#pragma unroll
    for (int i = 0; i < 2; ++i) {
      const int c = c0 + 32 * i;
      uint4 o;
      o.x = pack2(tile[(r8 + 0) * 65 + c], tile[(r8 + 1) * 65 + c]);
      o.y = pack2(tile[(r8 + 2) * 65 + c], tile[(r8 + 3) * 65 + c]);
      o.z = pack2(tile[(r8 + 4) * 65 + c], tile[(r8 + 5) * 65 + c]);
      o.w = pack2(tile[(r8 + 6) * 65 + c], tile[(r8 + 7) * 65 + c]);
      *(uint4*)(dst + (size_t)c * dld + r8) = o;
    }
  }
  __syncthreads();
}

__device__ void weight_tile(const Params& p, int job, float* tile) {
  const int NT_LAYER = 832 + 1024 + 256 + 256;
  {
      int l = job / NT_LAYER, j = job % NT_LAYER;
      if (j < 832) {
        int kt = j / 52, nt = j % 52;
        transpose_tile(p.w_in + (size_t)l * 1024 * 3328 + (size_t)kt * 64 * 3328 + nt * 64, 3328,
                       (bf16_t*)(p.ws + WS_WIN) + (size_t)l * 3328 * 1024 + (size_t)nt * 64 * 1024 + kt * 64, 1024, tile);
      } else if (j < 832 + 1024) {
        j -= 832;
        int kt = j / 64, nt = j % 64;
        transpose_tile(p.w_mg + (size_t)l * 1024 * 4096 + (size_t)kt * 64 * 4096 + nt * 64, 4096,
                       (bf16_t*)(p.ws + WS_WMG) + (size_t)l * 4096 * 1024 + (size_t)nt * 64 * 1024 + kt * 64, 1024, tile);
      } else if (j < 832 + 1024 + 256) {
        j -= 832 + 1024;
        int n = j / 64, r = j % 64, wt = r / 16, mt = r % 16;
        transpose_tile(p.w_bo + ((size_t)(l * 4 + n) * 256 + wt * 64) * 1024 + mt * 64, 1024,
                       (bf16_t*)(p.ws + WS_WBO) + ((size_t)(l * 4 + n) * 1024 + mt * 64) * 256 + wt * 64, 256, tile);
      } else {
        j -= 832 + 1024 + 256;
        int kt = j / 16, nt = j % 16;
        transpose_tile(p.w_o + (size_t)l * 1024 * 1024 + (size_t)kt * 64 * 1024 + nt * 64, 1024,
                       (bf16_t*)(p.ws + WS_WO) + (size_t)l * 1024 * 1024 + (size_t)nt * 64 * 1024 + kt * 64, 1024, tile);
      }
  }
}

__device__ void phase_prep(const Params& p, unsigned char* lds) {
  float* tile = (float*)lds;
  const int NT_LAYER = 832 + 1024 + 256 + 256;
  const int NT_W = 2 * NT_LAYER;
  const int NT_LRU = 32;
  const int NT_CV = 512 + 512 + 256;
  const int NT_ALL = NT_W + NT_LRU + NT_CV;
  const int N_MOD = 384;
  const int NJ = NT_ALL + N_MOD + 1;
  bf16_t* wsb = (bf16_t*)p.ws;
  for (int job = blockIdx.x; job < NJ; job += gridDim.x) {
    if (job < NT_W) {
      if (job < 832) weight_tile(p, job, tile);
    } else if (job < NT_W + NT_LRU) {
      int j = job - NT_W;
      int gate = j & 1, rest = j >> 1;
      transpose_tile((gate ? p.lru_wx : p.lru_wa) + (size_t)rest * 4096, 64, (bf16_t*)(p.ws + WS_WLRU) + (size_t)j * 4096, 64, tile);
    } else if (job < NT_ALL) {
      int j = job - NT_W - NT_LRU;
      if (j < 512) {
        int mat = j >> 3, kt = j & 7;
        transpose_tile(p.cdv + (size_t)mat * 512 * 64 + (size_t)kt * 64 * 64, 64, (bf16_t*)(p.ws + WS_CVA) + (size_t)mat * 64 * 512 + kt * 64, 512, tile);
      } else if (j < 1024) {
        j -= 512;
        int mat = j >> 3, kt = j & 7;
        transpose_tile(p.cnv + (size_t)mat * 512 * 64 + (size_t)kt * 64 * 64, 64, (bf16_t*)(p.ws + WS_CVC) + (size_t)mat * 64 * 512 + kt * 64, 512, tile);
      } else {
        j -= 1024;
        int mat = j >> 3, kt = j & 7;
        transpose_tile(p.csv + (size_t)mat * 512 * 64 + (size_t)kt * 64 * 64, 64, (bf16_t*)(p.ws + WS_CVD) + (size_t)mat * 64 * 512 + kt * 64, 512, tile);
      }
    } else if (job < NT_ALL + N_MOD) {
      int j = job - NT_ALL;
      int l = j / 192, j0 = (j % 192) * 16;
      float* sc = (float*)lds;
      const int tid = TIDX;
      for (int e = tid; e < 9 * 1024; e += 256) {
        int v = e >> 10, k = e & 1023;
        float cvv = v == 0 ? p.c_ctx[k] : p.c[(v - 1) * 1024 + k];
        sc[e] = siluf_(cvv);
      }
      __syncthreads();
      const int jj = tid & 15, ks = tid >> 4;
      float acc[9];
#pragma unroll
      for (int v = 0; v < 9; ++v) acc[v] = 0.f;
      const float* wp = p.w_ada + (size_t)l * 1024 * 3072 + j0 + jj;
#pragma unroll 8
      for (int kk = 0; kk < 64; ++kk) {
        int k = ks * 64 + kk;
        float w = wp[(size_t)k * 3072];
#pragma unroll
        for (int v = 0; v < 9; ++v) acc[v] += sc[v * 1024 + k] * w;
      }
      __syncthreads();
      float* red = (float*)lds;
#pragma unroll
      for (int v = 0; v < 9; ++v) red[(ks * 9 + v) * 16 + jj] = acc[v];
      __syncthreads();
      if (tid < 144) {
        int v = tid >> 4, j2 = tid & 15;
        float s = p.b_ada[(size_t)l * 3072 + j0 + j2];
        for (int q = 0; q < 16; ++q) s += red[(q * 9 + v) * 16 + j2];
        ((float*)(p.ws + WS_MOD))[((size_t)l * 9 + v) * 3072 + j0 + j2] = s;
      }
      __syncthreads();
    } else {
      float2* ta = (float2*)(p.ws + WS_TABA);
      float2* td = (float2*)(p.ws + WS_TABD);
      for (int e = TIDX; e < 64 * 8 + 64 * 16; e += 256) {
        if (e < 512) {
          int pos = e >> 3, i = e & 7;
          float inv = powf(10000.f, -(float)i / 8.f);
          float ang = (float)pos * inv;
          ta[e] = make_float2(cosf(ang), sinf(ang));
        } else {
          int e2 = e - 512;
          int pos = e2 >> 4, i = e2 & 15;
          float inv = powf(10000.f, -(float)i / 16.f);
          float ang = (float)pos * inv;
          td[e2] = make_float2(cosf(ang), sinf(ang));
        }
      }
    }
  }
  (void)wsb;
}

__device__ void phase_norm(const Params& p, int l) {
  const int wave = TIDX >> 6, lane = TIDX & 63;
  const float* modl = (const float*)(p.ws + WS_MOD) + (size_t)l * 9 * 3072;
  bf16_t* hb = (bf16_t*)(p.ws + WS_H);
  const float* gp = p.norm_g + l * 1024;
  for (int t = blockIdx.x * 4 + wave; t < T_TOK; t += gridDim.x * 4) {
    const float* xr = xrow(p, l, t);
    const int v = t < T_PR ? 0 : 1 + ((t - T_PR) >> 10);
    const float* shift = modl + v * 3072;
    const float* scale = shift + 1024;
    float4 xv[4];
    float ss = 0.f;
#pragma unroll
    for (int j = 0; j < 4; ++j) {
      xv[j] = *(const float4*)(xr + j * 256 + lane * 4);
      ss += xv[j].x * xv[j].x + xv[j].y * xv[j].y + xv[j].z * xv[j].z + xv[j].w * xv[j].w;
    }
    ss = wave_sum(ss);
    const float rinv = rsqrtf(ss * (1.f / 1024.f) + 1e-6f);
#pragma unroll
    for (int j = 0; j < 4; ++j) {
      const int c = j * 256 + lane * 4;
      float4 gg = *(const float4*)(gp + c), sc = *(const float4*)(scale + c), sh = *(const float4*)(shift + c);
      float h0 = xv[j].x * rinv * gg.x * (1.f + sc.x) + sh.x;
      float h1 = xv[j].y * rinv * gg.y * (1.f + sc.y) + sh.y;
      float h2 = xv[j].z * rinv * gg.z * (1.f + sc.z) + sh.z;
      float h3 = xv[j].w * rinv * gg.w * (1.f + sc.w) + sh.w;
      uint2 o;
      o.x = pack2(h0, h1);
      o.y = pack2(h2, h3);
      *(uint2*)(hb + (size_t)t * 1024 + c) = o;
    }
  }
}

__device__ void phase_final(const Params& p) {
  const int wave = TIDX >> 6, lane = TIDX & 63;
  for (int t = blockIdx.x * 4 + wave; t < T_TOK; t += gridDim.x * 4) {
    float* xr = p.out + O_Y + (size_t)t * 1024;
    float4 xv[4];
    float ss = 0.f;
#pragma unroll
    for (int j = 0; j < 4; ++j) {
      xv[j] = *(const float4*)(xr + j * 256 + lane * 4);
      ss += xv[j].x * xv[j].x + xv[j].y * xv[j].y + xv[j].z * xv[j].z + xv[j].w * xv[j].w;
    }
    ss = wave_sum(ss);
    const float rinv = rsqrtf(ss * (1.f / 1024.f) + 1e-6f);
#pragma unroll
    for (int j = 0; j < 4; ++j) {
      const int c = j * 256 + lane * 4;
      float4 gg = *(const float4*)(p.norm_f + c);
      float4 o;
      o.x = xv[j].x * rinv * gg.x;
      o.y = xv[j].y * rinv * gg.y;
      o.z = xv[j].z * rinv * gg.z;
      o.w = xv[j].w * rinv * gg.w;
      *(float4*)(xr + c) = o;
    }
  }
}

__device__ __forceinline__ int next_tile(unsigned* ctrs, int per_list, bool first, volatile int* sjob) {
  __syncthreads();
  if (threadIdx.x == 0) {
    int res = -1;
    int cur = first ? 0 : sjob[1];
    const unsigned x = xb_xcc_id();
    while (cur < 8) {
      const int lst = (int)((x + (unsigned)cur) & 7u);
      const int v = (int)xb_add(ctrs + lst * 16, 1u);
      if (v < per_list) { res = lst * per_list + v; break; }
      ++cur;
    }
    sjob[1] = cur;
    sjob[0] = res;
  }
  __syncthreads();
  return sjob[0];
}

#define LDT 80
#define LDV 72
template <int NI, bool FDB = true, bool SWAP = false>
__device__ __forceinline__ void gemm_accum(f32x4 (&acc)[4][NI], const bf16_t* __restrict__ A, int lda,
                                           const bf16_t* __restrict__ Bt, int ldb, int K, bf16_t* As, bf16_t* Bs, int bqrows = 32) {
  const int tid = TIDX, lane = tid & 63, wave = tid >> 6, wm = wave >> 1, wn = wave & 1, g = lane >> 4, c16 = lane & 15;
  const int lr = tid >> 3, lc = (tid & 7) * 8;
  const bf16_t* ap = A + (size_t)lr * lda + lc;
  const bf16_t* bp = Bt + (size_t)lr * ldb + lc;
  const size_t a32 = (size_t)32 * lda, b32 = (size_t)bqrows * ldb;
  uint4 ra0 = *(const uint4*)(ap), ra1 = *(const uint4*)(ap + a32), ra2 = *(const uint4*)(ap + 2 * a32), ra3 = *(const uint4*)(ap + 3 * a32);
  uint4 rb0 = *(const uint4*)(bp), rb1 = *(const uint4*)(bp + b32), rb2, rb3;
  if (NI == 4) { rb2 = *(const uint4*)(bp + 2 * b32); rb3 = *(const uint4*)(bp + 3 * b32); }
  for (int k0 = 0; k0 < K; k0 += 64) {
    *(uint4*)(As + (lr + 0) * LDT + lc) = ra0;
    *(uint4*)(As + (lr + 32) * LDT + lc) = ra1;
    *(uint4*)(As + (lr + 64) * LDT + lc) = ra2;
    *(uint4*)(As + (lr + 96) * LDT + lc) = ra3;
    *(uint4*)(Bs + (lr + 0) * LDT + lc) = rb0;
    *(uint4*)(Bs + (lr + 32) * LDT + lc) = rb1;
    if (NI == 4) {
      *(uint4*)(Bs + (lr + 64) * LDT + lc) = rb2;
      *(uint4*)(Bs + (lr + 96) * LDT + lc) = rb3;
    }
    __syncthreads();
    {
      const int kn = (k0 + 64 < K) ? k0 + 64 : k0;
      ra0 = *(const uint4*)(ap + kn);
      ra1 = *(const uint4*)(ap + a32 + kn);
      ra2 = *(const uint4*)(ap + 2 * a32 + kn);
      ra3 = *(const uint4*)(ap + 3 * a32 + kn);
      rb0 = *(const uint4*)(bp + kn);
      rb1 = *(const uint4*)(bp + b32 + kn);
      if (NI == 4) {
        rb2 = *(const uint4*)(bp + 2 * b32 + kn);
        rb3 = *(const uint4*)(bp + 3 * b32 + kn);
      }
    }
    __builtin_amdgcn_sched_barrier(0);
    if (FDB) {
      bf16x8 af0[4], bf0[NI], af1[4], bf1[NI];
      const bf16_t* arow = As + (wm * 64 + c16) * LDT + g * 8;
      const bf16_t* brow = Bs + (wn * 16 * NI + c16) * LDT + g * 8;
#pragma unroll
      for (int i = 0; i < 4; ++i) af0[i] = *(const bf16x8*)(arow + i * 16 * LDT);
#pragma unroll
      for (int j = 0; j < NI; ++j) bf0[j] = *(const bf16x8*)(brow + j * 16 * LDT);
#pragma unroll
      for (int i = 0; i < 4; ++i) af1[i] = *(const bf16x8*)(arow + i * 16 * LDT + 32);
#pragma unroll
      for (int j = 0; j < NI; ++j) bf1[j] = *(const bf16x8*)(brow + j * 16 * LDT + 32);
      __builtin_amdgcn_sched_barrier(0);
#pragma unroll
      for (int i = 0; i < 4; ++i)
#pragma unroll
        for (int j = 0; j < NI; ++j) acc[i][j] = SWAP ? mfma16(bf0[j], af0[i], acc[i][j]) : mfma16(af0[i], bf0[j], acc[i][j]);
#pragma unroll
      for (int i = 0; i < 4; ++i)
#pragma unroll
        for (int j = 0; j < NI; ++j) acc[i][j] = SWAP ? mfma16(bf1[j], af1[i], acc[i][j]) : mfma16(af1[i], bf1[j], acc[i][j]);
    } else {
#pragma unroll
      for (int ks = 0; ks < 2; ++ks) {
        bf16x8 af[4], bfr[NI];
#pragma unroll
        for (int i = 0; i < 4; ++i) af[i] = *(const bf16x8*)(As + (wm * 64 + i * 16 + c16) * LDT + ks * 32 + g * 8);
#pragma unroll
        for (int j = 0; j < NI; ++j) bfr[j] = *(const bf16x8*)(Bs + (wn * 16 * NI + j * 16 + c16) * LDT + ks * 32 + g * 8);
#pragma unroll
        for (int i = 0; i < 4; ++i)
#pragma unroll
          for (int j = 0; j < NI; ++j) acc[i][j] = SWAP ? mfma16(bfr[j], af[i], acc[i][j]) : mfma16(af[i], bfr[j], acc[i][j]);
      }
    }
    __syncthreads();
  }
}

__device__ void phase_gemm1(const Params& p, int l, unsigned char* lds) {
  bf16_t* As = (bf16_t*)lds;
  bf16_t* Bs = As + 128 * LDT;
  const bf16_t* hb = (const bf16_t*)(p.ws + WS_H);
  const bf16_t* wt = (const bf16_t*)(p.ws + WS_WIN) + (size_t)l * 3328 * 1024;
  bf16_t* hin = (bf16_t*)(p.ws + WS_HIN);
  const float2* tabA = (const float2*)(p.ws + WS_TABA);
  const float2* tabD = (const float2*)(p.ws + WS_TABD);
  const int lane = TIDX & 63, wave = TIDX >> 6, wm = wave >> 1, wn = wave & 1, g = lane >> 4, c16 = lane & 15;
  unsigned* ctrs = (unsigned*)(p.ws + WS_BAR) + XB_JOBCTR(8 + l * 24);
  volatile int* sjob = (volatile int*)(lds + LDS_BYTES - 16);
  for (int tile = blockIdx.x; tile < 96 * 26; tile += gridDim.x) {
    const int rt = tile / 26, ct = tile % 26;
    const int row0 = rt * 128, col0 = ct * 128;
    f32x4 acc[4][4];
#pragma unroll
    for (int i = 0; i < 4; ++i)
#pragma unroll
      for (int j = 0; j < 4; ++j) acc[i][j] = (f32x4){0.f, 0.f, 0.f, 0.f};
    const bool vtile = (col0 >= 1536 && col0 < 1792) || (col0 >= 2560 && col0 < 2816) || col0 >= 3200;
    const int cw = col0 + wn * 64;
    const int rw = row0 + wm * 64;
    const bool sample = row0 >= T_PR;
    int b, pbase, L;
    if (!sample) { b = rw >> 8; pbase = rw & 255; L = 256; }
    else { b = (rw - T_PR) >> 10; pbase = (rw - T_PR) & 1023; L = 1024; }
    if (vtile) {
      gemm_accum<4, true, false>(acc, hb + (size_t)row0 * 1024, 1024, wt + (size_t)col0 * 1024, 1024, 1024, As, Bs);
      int vkind, vhead, vnh = 4;
      if (cw < 1792) { vkind = 0; vhead = (cw - 1536) >> 6; }
      else if (cw < 2816) { vkind = 1; vhead = (cw - 2560) >> 6; }
      else { vkind = 2; vhead = (cw - 3200) >> 6; vnh = 2; }
      bf16_t* vt = (bf16_t*)(p.ws + (vkind == 0 ? WS_AVT : vkind == 1 ? WS_CVT : WS_DVT));
      const size_t base = sample ? (size_t)16 * vnh * 64 * 256 + (size_t)(b * vnh + vhead) * 64 * 1024 : (size_t)(b * vnh + vhead) * 64 * 256;
#pragma unroll
      for (int mi = 0; mi < 4; ++mi)
#pragma unroll
        for (int ni = 0; ni < 4; ++ni) {
          const int d = ni * 16 + c16;
          uint2 o;
          o.x = pack2(acc[mi][ni][0], acc[mi][ni][1]);
          o.y = pack2(acc[mi][ni][2], acc[mi][ni][3]);
          *(uint2*)(vt + base + (size_t)d * L + pbase + mi * 16 + g * 4) = o;
        }
      if (!sample) {
        float* ob = p.out + (vkind == 0 ? O_DV : vkind == 1 ? O_NV : O_SV) + (size_t)((b * 2 + l) * vnh + vhead) * 256 * 64;
#pragma unroll
        for (int mi = 0; mi < 4; ++mi)
#pragma unroll
          for (int i = 0; i < 4; ++i) {
            const int pos = pbase + mi * 16 + g * 4 + i;
#pragma unroll
            for (int ni = 0; ni < 4; ++ni) ob[(size_t)pos * 64 + ni * 16 + c16] = acc[mi][ni][i];
          }
      }
    } else {
      gemm_accum<4, true, true>(acc, hb + (size_t)row0 * 1024, 1024, wt + (size_t)col0 * 1024, 1024, 1024, As, Bs);
      const bool ropeA = sample && cw >= 1024 && cw < 1536;
      const bool ropeD = sample && cw >= 2816 && cw < 3200;
      if (ropeA) {
#pragma unroll
        for (int i = 0; i < 4; ++i) {
          const int pos = pbase + i * 16 + c16;
          const int prow = pos >> 6, pcol = pos & 63;
#pragma unroll
          for (int j = 0; j < 4; ++j)
#pragma unroll
            for (int r = 0; r < 4; ++r) {
              const float2 cs = tabA[((j & 1) ? pcol : prow) * 8 + (g & 1) * 4 + r];
              const float own = acc[i][j][r];
              const float oth = __shfl_xor(own, 32);
              acc[i][j][r] = (g < 2) ? (own * cs.x - oth * cs.y) : (oth * cs.y + own * cs.x);
            }
        }
      } else if (ropeD) {
#pragma unroll
        for (int i = 0; i < 4; ++i) {
          const int pos = pbase + i * 16 + c16;
          const int prow = pos >> 6, pcol = pos & 63;
#pragma unroll
          for (int r = 0; r < 4; ++r) {
            {
              const float2 cs = tabD[prow * 16 + g * 4 + r];
              const float x1 = acc[i][0][r], x2 = acc[i][1][r];
              acc[i][0][r] = x1 * cs.x - x2 * cs.y;
              acc[i][1][r] = x1 * cs.y + x2 * cs.x;
            }
            {
              const float2 cs = tabD[pcol * 16 + g * 4 + r];
              const float x1 = acc[i][2][r], x2 = acc[i][3][r];
              acc[i][2][r] = x1 * cs.x - x2 * cs.y;
              acc[i][3][r] = x1 * cs.y + x2 * cs.x;
            }
          }
        }
      }
#pragma unroll
      for (int i = 0; i < 4; ++i) {
        const size_t r = (size_t)(rw + i * 16 + c16);
#pragma unroll
        for (int j = 0; j < 4; ++j) {
          uint2 o;
          o.x = pack2(acc[i][j][0], acc[i][j][1]);
          o.y = pack2(acc[i][j][2], acc[i][j][3]);
          *(uint2*)(hin + r * INW + cw + j * 16 + g * 4) = o;
        }
      }
      if (!sample) {
        float* ob = nullptr;
        int kind = -1;
        if (cw >= 1280 && cw < 1536) { kind = 0; ob = p.out + O_DK + ((size_t)((b * 2 + l) * 4 + ((cw - 1280) >> 6)) * 2) * 256 * 32; }
        else if (cw >= 2304 && cw < 2560) { kind = 1; ob = p.out + O_NK + (size_t)((b * 2 + l) * 4 + ((cw - 2304) >> 6)) * 256 * 64; }
        else if (cw >= 3072 && cw < 3200) { kind = 1; ob = p.out + O_SK + (size_t)((b * 2 + l) * 2 + ((cw - 3072) >> 6)) * 256 * 64; }
        if (kind == 0) {
#pragma unroll
          for (int i = 0; i < 4; ++i) {
            const int pos = pbase + i * 16 + c16;
#pragma unroll
            for (int j = 0; j < 4; ++j) {
              const float4 o = {acc[i][j][0], acc[i][j][1], acc[i][j][2], acc[i][j][3]};
              *(float4*)(ob + ((size_t)(j >> 1) * 256 + pos) * 32 + (j & 1) * 16 + g * 4) = o;
            }
          }
        } else if (kind == 1) {
#pragma unroll
          for (int i = 0; i < 4; ++i) {
            const int pos = pbase + i * 16 + c16;
#pragma unroll
            for (int j = 0; j < 4; ++j) {
              const float4 o = {acc[i][j][0], acc[i][j][1], acc[i][j][2], acc[i][j][3]};
              *(float4*)(ob + (size_t)pos * 64 + j * 16 + g * 4) = o;
            }
          }
        }
      }
    }
  }
}

__device__ void phase_merge(const Params& p, int l, unsigned char* lds) {
  bf16_t* As = (bf16_t*)lds;
  bf16_t* Bs = As + 128 * LDT;
  const bf16_t* hb = (const bf16_t*)(p.ws + WS_H);
  const bf16_t* br = (const bf16_t*)(p.ws + WS_BR);
  const bf16_t* wmg = (const bf16_t*)(p.ws + WS_WMG) + (size_t)l * 4096 * 1024;
  const bf16_t* wbo = (const bf16_t*)(p.ws + WS_WBO) + (size_t)l * 4 * 1024 * 256;
  bf16_t* mb = (bf16_t*)(p.ws + WS_MB);
  unsigned* ctrs = (unsigned*)(p.ws + WS_BAR) + XB_JOBCTR(16 + l * 24);
  volatile int* sjob = (volatile int*)(lds + LDS_BYTES - 16);
  for (int tile = blockIdx.x; tile < 96 * 8; tile += gridDim.x) {
    const int rt = tile >> 3, ct = tile & 7;
    const int row0 = rt * 128, col0 = ct * 128;
    f32x4 macc[4][4];
#pragma unroll
    for (int i = 0; i < 4; ++i)
#pragma unroll
      for (int j = 0; j < 4; ++j) macc[i][j] = (f32x4){0.f, 0.f, 0.f, 0.f};
#pragma unroll 1
    for (int n = 0; n < 4; ++n) {
      uint2 gp[4][4];
      {
        f32x4 G[4][4];
#pragma unroll
        for (int i = 0; i < 4; ++i)
#pragma unroll
          for (int j = 0; j < 4; ++j) G[i][j] = (f32x4){0.f, 0.f, 0.f, 0.f};
        gemm_accum<4, false, true>(G, hb + (size_t)row0 * 1024, 1024, wmg + (size_t)(n * 1024 + col0) * 1024, 1024, 1024, As, Bs);
        const int lane1 = TIDX & 63, wn1 = (TIDX >> 6) & 1, g1 = lane1 >> 4;
#pragma unroll
        for (int j = 0; j < 4; ++j) {
          const float4 bb = *(const float4*)(p.b_mg + (size_t)l * 4096 + n * 1024 + col0 + wn1 * 64 + j * 16 + g1 * 4);
#pragma unroll
          for (int i = 0; i < 4; ++i) {
            gp[i][j].x = pack2(sigmoidf_(G[i][j][0] + bb.x), sigmoidf_(G[i][j][1] + bb.y));
            gp[i][j].y = pack2(sigmoidf_(G[i][j][2] + bb.z), sigmoidf_(G[i][j][3] + bb.w));
          }
        }
      }
#pragma unroll
      for (int hh = 0; hh < 2; ++hh) {
        f32x4 Pa[4][2];
#pragma unroll
        for (int i = 0; i < 4; ++i)
#pragma unroll
          for (int j = 0; j < 2; ++j) Pa[i][j] = (f32x4){0.f, 0.f, 0.f, 0.f};
        gemm_accum<2, true, true>(Pa, br + (size_t)row0 * 1024 + n * 256, 1024, wbo + (size_t)(n * 1024 + col0 + hh * 32) * 256, 256, 256, As, Bs, 64);
#pragma unroll
        for (int i = 0; i < 4; ++i)
#pragma unroll
          for (int j = 0; j < 2; ++j) {
            macc[i][hh * 2 + j][0] += lo2f(gp[i][hh * 2 + j].x) * Pa[i][j][0];
            macc[i][hh * 2 + j][1] += hi2f(gp[i][hh * 2 + j].x) * Pa[i][j][1];
            macc[i][hh * 2 + j][2] += lo2f(gp[i][hh * 2 + j].y) * Pa[i][j][2];
            macc[i][hh * 2 + j][3] += hi2f(gp[i][hh * 2 + j].y) * Pa[i][j][3];
          }
      }
    }
    const int lane = TIDX & 63, wave = TIDX >> 6, wm = wave >> 1, wn = wave & 1, g = lane >> 4, c16 = lane & 15;
#pragma unroll
    for (int i = 0; i < 4; ++i) {
      const size_t r = (size_t)(row0 + wm * 64 + i * 16 + c16);
#pragma unroll
      for (int j = 0; j < 4; ++j) {
        uint2 o;
        o.x = pack2(macc[i][j][0], macc[i][j][1]);
        o.y = pack2(macc[i][j][2], macc[i][j][3]);
        *(uint2*)(mb + r * 1024 + col0 + wn * 64 + j * 16 + g * 4) = o;
      }
    }
  }
}

__device__ void phase_out(const Params& p, int l, unsigned char* lds) {
  bf16_t* As = (bf16_t*)lds;
  bf16_t* Bs = As + 128 * LDT;
  const bf16_t* mb = (const bf16_t*)(p.ws + WS_MB);
  const bf16_t* wo = (const bf16_t*)(p.ws + WS_WO) + (size_t)l * 1024 * 1024;
  const float* modl = (const float*)(p.ws + WS_MOD) + (size_t)l * 9 * 3072;
  const int lane = TIDX & 63, wave = TIDX >> 6, wm = wave >> 1, wn = wave & 1, g = lane >> 4, c16 = lane & 15;
  unsigned* ctrs = (unsigned*)(p.ws + WS_BAR) + XB_JOBCTR(24 + l * 24);
  volatile int* sjob = (volatile int*)(lds + LDS_BYTES - 16);
  for (int tile = blockIdx.x; tile < 96 * 8; tile += gridDim.x) {
    const int rt = tile >> 3, ct = tile & 7;
    const int row0 = rt * 128, col0 = ct * 128;
    f32x4 acc[4][4];
#pragma unroll
    for (int i = 0; i < 4; ++i)
#pragma unroll
      for (int j = 0; j < 4; ++j) acc[i][j] = (f32x4){0.f, 0.f, 0.f, 0.f};
    gemm_accum<4, true, true>(acc, mb + (size_t)row0 * 1024, 1024, wo + (size_t)col0 * 1024, 1024, 1024, As, Bs);
    const int v = row0 < T_PR ? 0 : 1 + ((row0 - T_PR) >> 10);
    const float* gate = modl + v * 3072 + 2048;
#pragma unroll
    for (int j = 0; j < 4; ++j) {
      const int col = col0 + wn * 64 + j * 16 + g * 4;
      const float4 gt = *(const float4*)(gate + col);
#pragma unroll
      for (int i = 0; i < 4; ++i) {
        const int t = row0 + wm * 64 + i * 16 + c16;
        const float4 xo = *(const float4*)(xrow(p, l, t) + col);
        float4 o;
        o.x = xo.x + gt.x * acc[i][j][0];
        o.y = xo.y + gt.y * acc[i][j][1];
        o.z = xo.z + gt.z * acc[i][j][2];
        o.w = xo.w + gt.w * acc[i][j][3];
        *(float4*)(p.out + O_Y + (size_t)t * 1024 + col) = o;
      }
    }
  }
}

template <int NM, int MODE>
__device__ __forceinline__ void attn_chunk(const bf16_t* Ks, const bf16_t* Vts, int koff, const bf16x8 (&qf)[2], float scale,
                                           float (&m_run)[NM], float (&l_run)[NM], f32x4 (&o)[NM][4], int lane,
                                           int qa, int qb, int ka, const float* rpbh) {
  const int g = lane >> 4, r16 = lane & 15;
  f32x4 s[NM][2];
#pragma unroll
  for (int kt = 0; kt < 2; ++kt) {
    const bf16_t* kp = Ks + (koff + kt * 16 + r16) * LDT + g * 8;
    const bf16x8 k0 = *(const bf16x8*)kp;
    const bf16x8 k1 = *(const bf16x8*)(kp + 32);
    const f32x4 z = {0.f, 0.f, 0.f, 0.f};
    if (NM == 2) {
      s[0][kt] = mfma16(k0, qf[0], z);
      s[NM - 1][kt] = mfma16(k1, qf[1], z);
    } else {
      s[0][kt] = mfma16(k1, qf[1], mfma16(k0, qf[0], z));
    }
  }
  bool valid[2][4];
  float bias[2][4];
#pragma unroll
  for (int kt = 0; kt < 2; ++kt)
#pragma unroll
    for (int i = 0; i < 4; ++i) {
      valid[kt][i] = true;
      bias[kt][i] = 0.f;
      const int kk = koff + kt * 16 + g * 4 + i;
      if (MODE == 1) {
        int cs = qb - 8;
        cs = cs < 0 ? 0 : (cs > 48 ? 48 : cs);
        const bool ok = (kk >= cs) && (kk < cs + 16);
        valid[kt][i] = ok;
        int dc = kk - qb + 15;
        dc = dc < 0 ? 0 : (dc > 30 ? 30 : dc);
        bias[kt][i] = rpbh[(ka - qa + 7) * 31 + dc] * 1.4426950408889634f;
      } else if (MODE == 2) {
        const int kp = ka + kt * 16 + g * 4 + i;
        int df = qa - kp;
        df = df < 0 ? -df : df;
        valid[kt][i] = df <= 128;
      }
    }
  bf16x8 pb[NM];
#pragma unroll
  for (int m = 0; m < NM; ++m) {
    float x[2][4];
    float mx = -1e30f;
#pragma unroll
    for (int kt = 0; kt < 2; ++kt)
#pragma unroll
      for (int i = 0; i < 4; ++i) {
        float xv = MODE == 1 ? fmaf(s[m][kt][i], scale, bias[kt][i]) : s[m][kt][i] * scale;
        if (MODE != 0) xv = valid[kt][i] ? xv : -1e30f;
        x[kt][i] = xv;
        mx = fmaxf(mx, xv);
      }
    mx = rowmax4(mx);
    const float mn = fmaxf(m_run[m], mx);
    const float alpha = __builtin_amdgcn_exp2f(m_run[m] - mn);
    m_run[m] = mn;
    float ps = 0.f;
    float pv[8];
#pragma unroll
    for (int kt = 0; kt < 2; ++kt)
#pragma unroll
      for (int i = 0; i < 4; ++i) {
        float e = __builtin_amdgcn_exp2f(x[kt][i] - mn);
        if (MODE != 0) e = valid[kt][i] ? e : 0.f;
        pv[kt * 4 + i] = e;
        ps += e;
      }
    l_run[m] = l_run[m] * alpha + ps;
#pragma unroll
    for (int dt = 0; dt < 4; ++dt) {
      o[m][dt][0] *= alpha;
      o[m][dt][1] *= alpha;
      o[m][dt][2] *= alpha;
      o[m][dt][3] *= alpha;
    }
    union { bf16x8 v; unsigned u[4]; } pk;
    pk.u[0] = pack2(pv[0], pv[1]);
    pk.u[1] = pack2(pv[2], pv[3]);
    pk.u[2] = pack2(pv[4], pv[5]);
    pk.u[3] = pack2(pv[6], pv[7]);
    pb[m] = pk.v;
  }
#pragma unroll
  for (int dt = 0; dt < 4; ++dt) {
    const bf16_t* vp = Vts + (dt * 16 + r16) * LDV + koff + g * 4;
    union { bf16x8 v; uint2 u[2]; } vf;
    vf.u[0] = *(const uint2*)vp;
    vf.u[1] = *(const uint2*)(vp + 16);
#pragma unroll
    for (int m = 0; m < NM; ++m) o[m][dt] = mfma16(vf.v, pb[m], o[m][dt]);
  }
}

template <int NM, int MODE>
__device__ __forceinline__ void attn_tile64(const bf16_t* Ks, const bf16_t* Vts, const bf16x8 (&qf)[2],
                                            float (&m_run)[NM], float (&l_run)[NM], f32x4 (&o)[NM][4], int lane, int qa, int ka,
                                            bool first) {
  const int g = lane >> 4, r16 = lane & 15;
  f32x4 s[NM][4];
  f32x4 ci[NM];
#pragma unroll
  for (int m = 0; m < NM; ++m) {
    const float c = first ? 0.f : -m_run[m];
    ci[m] = (f32x4){c, c, c, c};
  }
#pragma unroll
  for (int kt = 0; kt < 4; ++kt) {
    const bf16_t* kp = Ks + (kt * 16 + r16) * LDT + g * 8;
    const bf16x8 k0 = *(const bf16x8*)kp;
    const bf16x8 k1 = *(const bf16x8*)(kp + 32);
    if (NM == 2) {
      s[0][kt] = mfma16(k0, qf[0], ci[0]);
      s[NM - 1][kt] = mfma16(k1, qf[1], ci[NM - 1]);
    } else {
      s[0][kt] = mfma16(k1, qf[1], mfma16(k0, qf[0], ci[0]));
    }
  }
  if (MODE == 2) {
#pragma unroll
    for (int kt = 0; kt < 4; ++kt)
#pragma unroll
      for (int i = 0; i < 4; ++i) {
        int df = qa - (ka + kt * 16 + g * 4 + i);
        df = df < 0 ? -df : df;
        const bool ok = df <= 128;
#pragma unroll
        for (int m = 0; m < NM; ++m) s[m][kt][i] = ok ? s[m][kt][i] : -1e30f;
      }
  }
  bf16x8 pbA[NM], pbB[NM];
#pragma unroll
  for (int m = 0; m < NM; ++m) {
    float mx = fmaxf(fmaxf(fmaxf(s[m][0][0], s[m][0][1]), fmaxf(s[m][0][2], s[m][0][3])),
                     fmaxf(fmaxf(s[m][1][0], s[m][1][1]), fmaxf(s[m][1][2], s[m][1][3])));
    mx = fmaxf(mx, fmaxf(fmaxf(fmaxf(s[m][2][0], s[m][2][1]), fmaxf(s[m][2][2], s[m][2][3])),
                         fmaxf(fmaxf(s[m][3][0], s[m][3][1]), fmaxf(s[m][3][2], s[m][3][3]))));
    mx = rowmax4(mx);
    if (first || __any(mx > 0.f)) {
      const float d = first ? mx : fmaxf(mx, 0.f);
      const float alpha = first ? 0.f : __builtin_amdgcn_exp2f(-d);
      m_run[m] = first ? d : m_run[m] + d;
      l_run[m] *= alpha;
#pragma unroll
      for (int dt = 0; dt < 4; ++dt) o[m][dt] *= alpha;
#pragma unroll
      for (int kt = 0; kt < 4; ++kt) s[m][kt] -= d;
    }
    f32x4 ps4 = {0.f, 0.f, 0.f, 0.f};
#pragma unroll
    for (int kt = 0; kt < 4; ++kt) {
      s[m][kt][0] = __builtin_amdgcn_exp2f(s[m][kt][0]);
      s[m][kt][1] = __builtin_amdgcn_exp2f(s[m][kt][1]);
      s[m][kt][2] = __builtin_amdgcn_exp2f(s[m][kt][2]);
      s[m][kt][3] = __builtin_amdgcn_exp2f(s[m][kt][3]);
      ps4 += s[m][kt];
    }
    l_run[m] += (ps4[0] + ps4[1]) + (ps4[2] + ps4[3]);
    union { bf16x8 v; unsigned u[4]; } pk;
    pk.u[0] = pack2(s[m][0][0], s[m][0][1]);
    pk.u[1] = pack2(s[m][0][2], s[m][0][3]);
    pk.u[2] = pack2(s[m][1][0], s[m][1][1]);
    pk.u[3] = pack2(s[m][1][2], s[m][1][3]);
    pbA[m] = pk.v;
    pk.u[0] = pack2(s[m][2][0], s[m][2][1]);
    pk.u[1] = pack2(s[m][2][2], s[m][2][3]);
    pk.u[2] = pack2(s[m][3][0], s[m][3][1]);
    pk.u[3] = pack2(s[m][3][2], s[m][3][3]);
    pbB[m] = pk.v;
  }
#pragma unroll
  for (int dt = 0; dt < 4; ++dt) {
    const bf16_t* vp = Vts + (dt * 16 + r16) * LDV + g * 4;
    union { bf16x8 v; uint2 u[2]; } vfA, vfB;
    vfA.u[0] = *(const uint2*)vp;
    vfA.u[1] = *(const uint2*)(vp + 16);
    vfB.u[0] = *(const uint2*)(vp + 32);
    vfB.u[1] = *(const uint2*)(vp + 48);
#pragma unroll
    for (int m = 0; m < NM; ++m) {
      o[m][dt] = mfma16(vfA.v, pbA[m], o[m][dt]);
      o[m][dt] = mfma16(vfB.v, pbB[m], o[m][dt]);
    }
  }
}

template <int BR, bool SAMPLE, int QG>
__device__ void attn_job(const Params& p, int l, int b, int head, int qp, unsigned char* lds) {
  constexpr int L = SAMPLE ? 1024 : 256;
  constexpr int NM = BR == 0 ? 2 : 1;
  constexpr int QCOL = BR == 0 ? 1024 : (BR == 2 ? 2048 : 2816);
  constexpr int KCOL = BR == 0 ? 1280 : (BR == 2 ? 2304 : 3072);
  constexpr int GCOL = BR == 0 ? 0 : (BR == 2 ? 512 : 768);
  constexpr int NKH = BR == 3 ? 2 : 4;
  bf16_t* Ks = (bf16_t*)lds;
  bf16_t* Vts = Ks + 64 * LDT;
  const int tid = TIDX, lane = tid & 63, w = tid >> 6, g = lane >> 4, qi = lane & 15;
  const int t0 = SAMPLE ? T_PR + b * 1024 : b * 256;
  int qpos[QG], tq[QG];
#pragma unroll
  for (int gq = 0; gq < QG; ++gq) {
    qpos[gq] = (QG * qp + gq) * 64 + w * 16 + qi;
    tq[gq] = t0 + qpos[gq];
  }
  const bf16_t* hin = (const bf16_t*)(p.ws + WS_HIN);
  const int kvh = BR == 3 ? (head >> 1) : head;
  const int kcol = KCOL + kvh * 64;
  const bf16_t* vT = (const bf16_t*)(p.ws + (BR == 0 ? WS_AVT : (BR == 2 ? WS_CVT : WS_DVT))) +
                     (SAMPLE ? (size_t)16 * NKH * 64 * 256 + (size_t)(b * NKH + kvh) * 64 * 1024 : (size_t)(b * NKH + kvh) * 64 * 256);
  const int cmat = (b * 2 + l) * NKH + kvh;
  const bf16_t* cvt = (const bf16_t*)(p.ws + (BR == 0 ? WS_CVA : (BR == 2 ? WS_CVC : WS_CVD))) + (size_t)cmat * 64 * 512;
  bf16x8 qf[QG][2];
  float m_run[QG][NM], l_run[QG][NM];
  f32x4 o[QG][NM][4];
#pragma unroll
  for (int gq = 0; gq < QG; ++gq) {
    qf[gq][0] = *(const bf16x8*)(hin + (size_t)tq[gq] * INW + QCOL + head * 64 + g * 8);
    qf[gq][1] = *(const bf16x8*)(hin + (size_t)tq[gq] * INW + QCOL + head * 64 + 32 + g * 8);
    const float qs = (BR == 0 ? 0.17677669529663687f : 0.125f) * 1.4426950408889634f;
#pragma unroll
    for (int i = 0; i < 2; ++i) {
      union { bf16x8 v; unsigned u[4]; } t;
      t.v = qf[gq][i];
#pragma unroll
      for (int w2 = 0; w2 < 4; ++w2) t.u[w2] = pack2(lo2f(t.u[w2]) * qs, hi2f(t.u[w2]) * qs);
      qf[gq][i] = t.v;
    }
#pragma unroll
    for (int m = 0; m < NM; ++m) {
      m_run[gq][m] = -1e30f;
      l_run[gq][m] = 0.f;
#pragma unroll
      for (int dt = 0; dt < 4; ++dt) o[gq][m][dt] = (f32x4){0.f, 0.f, 0.f, 0.f};
    }
    if (BR == 3) {
      m_run[gq][0] = p.sink[l * 4 + head] * 1.4426950408889634f;
      l_run[gq][0] = (g == 0) ? 1.f : 0.f;
    }
  }
  const float scale = 1.f;
  const int nctx = SAMPLE ? 8 : 0;
  int loc0 = 0, nloc = 4;
  int glo[QG], ghi[QG];
#pragma unroll
  for (int gq = 0; gq < QG; ++gq) { glo[gq] = 0; ghi[gq] = 3; }
  if (SAMPLE) {
#pragma unroll
    for (int gq = 0; gq < QG; ++gq) {
      const int qtg = QG * qp + gq;
      if (BR == 0) { glo[gq] = 0; ghi[gq] = 15; }
      else if (BR == 2) { int rs = qtg - 4; rs = rs < 0 ? 0 : (rs > 8 ? 8 : rs); glo[gq] = rs; ghi[gq] = rs + 7; }
      else { glo[gq] = qtg - 2 < 0 ? 0 : qtg - 2; ghi[gq] = qtg + 2 > 15 ? 15 : qtg + 2; }
    }
    loc0 = glo[0];
    nloc = ghi[QG - 1] - glo[0] + 1;
  }
  const float* rpbh = p.rpb + (size_t)(l * 4 + head) * 15 * 31;
  const int nb = w * 16 - 8;
  const int boff = nb < 0 ? 0 : (nb > 32 ? 32 : nb);
  const int ntl = nctx + nloc;
  const int skey = tid >> 2, sseg = tid & 3;
  float4 kr0 = make_float4(0.f, 0.f, 0.f, 0.f), kr1 = kr0, kr2 = kr0, kr3 = kr0;
  uint4 vr0, vr1;
#define ATT_ISSUE(IT2)                                                                                                   \
  {                                                                                                                      \
    const int it2_ = (IT2);                                                                                              \
    const bool c2 = it2_ < nctx;                                                                                         \
    const int kt2 = c2 ? it2_ : loc0 + (it2_ - nctx);                                                                    \
    if (c2) {                                                                                                            \
      const float* src;                                                                                                  \
      if (BR == 0) src = p.cdk + ((((size_t)(b * 2 + l) * 4 + head) * 2 + (sseg >> 1)) * 512 + kt2 * 64 + skey) * 32 + (sseg & 1) * 16; \
      else if (BR == 2) src = p.cnk + (((size_t)(b * 2 + l) * 4 + head) * 512 + kt2 * 64 + skey) * 64 + sseg * 16;      \
      else src = p.csk + (((size_t)(b * 2 + l) * 2 + kvh) * 512 + kt2 * 64 + skey) * 64 + sseg * 16;                     \
      kr0 = ((const float4*)src)[0];                                                                                     \
      kr1 = ((const float4*)src)[1];                                                                                     \
      kr2 = ((const float4*)src)[2];                                                                                     \
      kr3 = ((const float4*)src)[3];                                                                                     \
    } else {                                                                                                             \
      const bf16_t* src = hin + (size_t)(t0 + kt2 * 64 + skey) * INW + kcol + sseg * 16;                                 \
      kr0 = ((const float4*)src)[0];                                                                                     \
      kr1 = ((const float4*)src)[1];                                                                                     \
    }                                                                                                                    \
    const bf16_t* vsrc = c2 ? cvt + (size_t)skey * 512 + kt2 * 64 + sseg * 16 : vT + (size_t)skey * L + kt2 * 64 + sseg * 16; \
    vr0 = ((const uint4*)vsrc)[0];                                                                                       \
    vr1 = ((const uint4*)vsrc)[1];                                                                                       \
  }
#define ATT_WRITE(CTX, KB, VB)                                                                                        \
  {                                                                                                                      \
    uint4 u0, u1;                                                                                                        \
    if (CTX) {                                                                                                           \
      u0.x = pack2(kr0.x, kr0.y); u0.y = pack2(kr0.z, kr0.w); u0.z = pack2(kr1.x, kr1.y); u0.w = pack2(kr1.z, kr1.w);    \
      u1.x = pack2(kr2.x, kr2.y); u1.y = pack2(kr2.z, kr2.w); u1.z = pack2(kr3.x, kr3.y); u1.w = pack2(kr3.z, kr3.w);    \
    } else {                                                                                                             \
      u0 = __builtin_bit_cast(uint4, kr0);                                                                               \
      u1 = __builtin_bit_cast(uint4, kr1);                                                                               \
    }                                                                                                                    \
    *(uint4*)((KB) + skey * LDT + sseg * 16) = u0;                                                                       \
    *(uint4*)((KB) + skey * LDT + sseg * 16 + 8) = u1;                                                                   \
    *(uint4*)((VB) + skey * LDV + sseg * 16) = vr0;                                                                      \
    *(uint4*)((VB) + skey * LDV + sseg * 16 + 8) = vr1;                                                                  \
  }
  constexpr int KVB = 64 * LDT + 64 * LDV;
  __syncthreads();
  ATT_ISSUE(0)
  ATT_WRITE(0 < nctx, Ks, Vts)
  if (1 < ntl) ATT_ISSUE(1)
  __syncthreads();
  for (int it = 0; it < ntl; ++it) {
    const bool isctx = it < nctx;
    const int kt = isctx ? it : loc0 + (it - nctx);
    const bf16_t* Kc = Ks + (it & 1) * KVB;
    const bf16_t* Vc = Vts + (it & 1) * KVB;
    if (it + 1 < ntl) ATT_WRITE(it + 1 < nctx, Ks + ((it + 1) & 1) * KVB, Vts + ((it + 1) & 1) * KVB)
    if (it + 2 < ntl) ATT_ISSUE(it + 2)
#pragma unroll
    for (int gq = 0; gq < QG; ++gq) {
      if (!isctx && (kt < glo[gq] || kt > ghi[gq])) continue;
      if (SAMPLE && BR == 2 && !isctx) {
        attn_chunk<NM, 1>(Kc, Vc, boff, qf[gq], scale, m_run[gq], l_run[gq], o[gq], lane, QG * qp + gq, w * 16 + qi, kt, rpbh);
      } else if (SAMPLE && BR == 3 && !isctx) {
        attn_tile64<NM, 2>(Kc, Vc, qf[gq], m_run[gq], l_run[gq], o[gq], lane, qpos[gq], kt * 64, false);
      } else {
        attn_tile64<NM, 0>(Kc, Vc, qf[gq], m_run[gq], l_run[gq], o[gq], lane, 0, 0, BR != 3 && it == 0);
      }
    }
    __syncthreads();
  }
#undef ATT_WRITE
  float lam = 0.f, lam_init = 0.f;
  if (BR == 0) {
    float s01 = 0.f, s23 = 0.f;
    for (int e = 0; e < 32; ++e) {
      s01 += p.dlam[l * 128 + e] * p.dlam[l * 128 + 32 + e];
      s23 += p.dlam[l * 128 + 64 + e] * p.dlam[l * 128 + 96 + e];
    }
    lam_init = 0.8f - 0.6f * expf(-0.3f * (float)l);
    lam = expf(s01) - expf(s23) + lam_init;
  }
  bf16_t* br = (bf16_t*)(p.ws + WS_BR);
#pragma unroll
  for (int gq = 0; gq < QG; ++gq) {
    float linv[NM];
#pragma unroll
    for (int m = 0; m < NM; ++m) {
      float lt = l_run[gq][m];
      lt += __shfl_xor(lt, 16);
      lt += __shfl_xor(lt, 32);
      linv[m] = 1.f / lt;
    }
    float y[4][4];
    if (BR == 0) {
      float ss = 0.f;
#pragma unroll
      for (int dt = 0; dt < 4; ++dt)
#pragma unroll
        for (int i = 0; i < 4; ++i) {
          float v = o[gq][0][dt][i] * linv[0] - lam * (o[gq][NM - 1][dt][i] * linv[NM - 1]);
          y[dt][i] = v;
          ss += v * v;
        }
      ss += __shfl_xor(ss, 16);
      ss += __shfl_xor(ss, 32);
      const float rinv = rsqrtf(ss * (1.f / 64.f) + 1e-6f) * (1.f - lam_init);
#pragma unroll
      for (int dt = 0; dt < 4; ++dt)
#pragma unroll
        for (int i = 0; i < 4; ++i) y[dt][i] *= rinv * p.dg[l * 64 + dt * 16 + g * 4 + i];
    } else {
#pragma unroll
      for (int dt = 0; dt < 4; ++dt)
#pragma unroll
        for (int i = 0; i < 4; ++i) y[dt][i] = o[gq][0][dt][i] * linv[0];
    }
#pragma unroll
    for (int dt = 0; dt < 4; ++dt) {
      const int d = dt * 16 + g * 4;
      const uint2 gv = *(const uint2*)(hin + (size_t)tq[gq] * INW + GCOL + head * 64 + d);
      uint2 ov;
      ov.x = pack2(y[dt][0] * siluf_(lo2f(gv.x)), y[dt][1] * siluf_(hi2f(gv.x)));
      ov.y = pack2(y[dt][2] * siluf_(lo2f(gv.y)), y[dt][3] * siluf_(hi2f(gv.y)));
      *(uint2*)(br + (size_t)tq[gq] * 1024 + GCOL + head * 64 + d) = ov;
    }
  }
}

__device__ void lru_job(const Params& p, int l, int seq, int n, int half, unsigned char* lds) {
  const bool sample = seq >= 16;
  const int b = sample ? seq - 16 : seq;
  const int L = sample ? 1024 : 256;
  const int t0 = sample ? T_PR + b * 1024 : b * 256;
  const int tid = TIDX, dir = tid >> 7, gt = tid & 127, gw = (tid >> 6) & 1, lane = tid & 63, g = lane >> 4, c16 = lane & 15;
  unsigned char* base = lds + dir * 26112;
  bf16_t* bxs = (bf16_t*)base;
  bf16_t* xcb = (bf16_t*)(base + 4480);
  float* xcf = (float*)(base + 4480 + 5120);
  float* af = (float*)(base + 4480 + 5120 + 8192);
  const bf16_t* hin = (const bf16_t*)(p.ws + WS_HIN);
  const bf16_t* wl = (const bf16_t*)(p.ws + WS_WLRU) + (size_t)(((l * 2 + dir) * 4 + n) * 2) * 4096;
  bf16x8 wf[2][2][2];
#pragma unroll
  for (int gate = 0; gate < 2; ++gate)
#pragma unroll
    for (int kk = 0; kk < 2; ++kk)
#pragma unroll
      for (int ks = 0; ks < 2; ++ks)
        wf[gate][kk][ks] = *(const bf16x8*)(wl + (size_t)gate * 4096 + ((2 * gw + kk) * 16 + c16) * 64 + ks * 32 + g * 8);
  float ba[2], bx[2], sp[2];
#pragma unroll
  for (int kk = 0; kk < 2; ++kk) {
    const int ch = n * 64 + (2 * gw + kk) * 16 + c16;
    ba[kk] = p.lru_ba[(l * 2 + dir) * 256 + ch];
    bx[kk] = p.lru_bx[(l * 2 + dir) * 256 + ch];
    const float lm = p.lru_lam[(l * 2 + dir) * 256 + ch];
    sp[kk] = -8.f * log1pf(expf(-lm));
  }
  const int cch = n * 64 + lane;
  const float cw0 = p.conv_w[(l * 4 + 0) * 256 + cch], cw1 = p.conv_w[(l * 4 + 1) * 256 + cch], cw2 = p.conv_w[(l * 4 + 2) * 256 + cch],
              cw3 = p.conv_w[(l * 4 + 3) * 256 + cch], cb = p.conv_b[l * 256 + cch];
  const bool split = half >= 0;
  const bool dep = split && (dir == 0 ? half == 1 : half == 0);
  float h = 0.f, pp = 1.f;
  if (sample && !dep) h = p.state[((size_t)(b * 2 + l) * 2 + dir) * 256 + n * 64 + lane];
  float* pbuf = (float*)(p.ws + WS_PB);
  float* yown = (float*)(p.ws + (dir == 0 ? WS_YF : WS_YB));
  const float* yoth = (const float*)(p.ws + (dir == 0 ? WS_YB : WS_YF));
  bf16_t* br = (bf16_t*)(p.ws + WS_BR);
  const int nch = split ? 16 : L / 32;
  const int c_lo = split ? half * 16 : 0;
  uint4 rw0, rw1, rw2;
#define LRU_ISSUE(CC)                                                                                               \
  {                                                                                                                    \
    const int cc_ = (CC);                                                                                              \
    {                                                                                                                  \
      const int idx = gt, r = idx >> 3, sg = idx & 7, pos = cc_ * 32 - 1 + r;                                          \
      const bool ok = pos >= 0 && pos < L;                                                                             \
      const int pc = ok ? pos : 0;                                                                                     \
      uint4 v = *(const uint4*)(hin + (size_t)(t0 + pc) * INW + 1792 + n * 64 + sg * 8);                               \
      rw0.x = ok ? v.x : 0u; rw0.y = ok ? v.y : 0u; rw0.z = ok ? v.z : 0u; rw0.w = ok ? v.w : 0u;                      \
    }                                                                                                                  \
    {                                                                                                                  \
      const int idx = gt + 128, r = idx >> 3, sg = idx & 7, pos = cc_ * 32 - 1 + r;                                    \
      const bool ok = pos >= 0 && pos < L;                                                                             \
      const int pc = ok ? pos : 0;                                                                                     \
      uint4 v = *(const uint4*)(hin + (size_t)(t0 + pc) * INW + 1792 + n * 64 + sg * 8);                               \
      rw1.x = ok ? v.x : 0u; rw1.y = ok ? v.y : 0u; rw1.z = ok ? v.z : 0u; rw1.w = ok ? v.w : 0u;                      \
    }                                                                                                                  \
    {                                                                                                                  \
      const int idx = gt + 256, r = idx >> 3, sg = idx & 7, pos = cc_ * 32 - 1 + r;                                    \
      const bool ok = idx < 280 && pos >= 0 && pos < L;                                                                \
      const int pc = ok ? pos : 0;                                                                                     \
      uint4 v = *(const uint4*)(hin + (size_t)(t0 + pc) * INW + 1792 + n * 64 + sg * 8);                               \
      rw2.x = ok ? v.x : 0u; rw2.y = ok ? v.y : 0u; rw2.z = ok ? v.z : 0u; rw2.w = ok ? v.w : 0u;                      \
    }                                                                                                                  \
  }
#define LRU_WRITE()                                                                         \
  {                                                                                         \
    *(uint4*)(bxs + (gt >> 3) * 64 + (gt & 7) * 8) = rw0;                                   \
    *(uint4*)(bxs + ((gt + 128) >> 3) * 64 + (gt & 7) * 8) = rw1;                           \
    if (gt + 256 < 280) *(uint4*)(bxs + ((gt + 256) >> 3) * 64 + (gt & 7) * 8) = rw2;       \
  }
  LRU_ISSUE(c_lo + (dir == 0 ? 0 : nch - 1))
  LRU_WRITE()
  for (int ci = 0; ci < nch; ++ci) {
    const int c = c_lo + (dir == 0 ? ci : nch - 1 - ci);
    const bool combine = !split && ci >= (nch >> 1);
    __syncthreads();
    if (ci + 1 < nch) LRU_ISSUE(dir == 0 ? c + 1 : c - 1)
    float4 py[4];
    uint2 pg[4];
    if (combine) {
#pragma unroll
      for (int q = 0; q < 4; ++q) {
        const int idx = gt + 128 * q, tok = idx >> 4, c4 = (idx & 15) * 4;
        const size_t t = (size_t)(t0 + c * 32 + tok);
        py[q] = *(const float4*)(yoth + t * 256 + n * 64 + c4);
        pg[q] = *(const uint2*)(hin + t * INW + 256 + n * 64 + c4);
      }
    }
    {
      const int tk0 = gw * 16;
      float xm1 = bf2f(bxs[(tk0 + 0) * 64 + lane]), x0 = bf2f(bxs[(tk0 + 1) * 64 + lane]), x1 = bf2f(bxs[(tk0 + 2) * 64 + lane]);
#pragma unroll
      for (int e = 0; e < 16; ++e) {
        const int tok = tk0 + e;
        const float x2 = bf2f(bxs[(tok + 3) * 64 + lane]);
        const float xc = cb + xm1 * cw0 + x0 * cw1 + x1 * cw2 + x2 * cw3;
        xcf[tok * 64 + lane] = xc;
        xcb[tok * LDT + lane] = f2bf(xc);
        xm1 = x0; x0 = x1; x1 = x2;
      }
    }
    __syncthreads();
    {
#pragma unroll
      for (int mt = 0; mt < 2; ++mt) {
        const bf16x8 a0 = *(const bf16x8*)(xcb + (mt * 16 + c16) * LDT + g * 8);
        const bf16x8 a1 = *(const bf16x8*)(xcb + (mt * 16 + c16) * LDT + 32 + g * 8);
#pragma unroll
        for (int kk = 0; kk < 2; ++kk) {
          const f32x4 z = {0.f, 0.f, 0.f, 0.f};
          f32x4 ar = mfma16(a1, wf[0][kk][1], mfma16(a0, wf[0][kk][0], z));
          f32x4 ai = mfma16(a1, wf[1][kk][1], mfma16(a0, wf[1][kk][0], z));
          const int ch = (2 * gw + kk) * 16 + c16;
#pragma unroll
          for (int i = 0; i < 4; ++i) {
            const int tok = mt * 16 + g * 4 + i;
            const float r = sigmoidf_(ar[i] + ba[kk]);
            const float ig = sigmoidf_(ai[i] + bx[kk]);
            const float a = __expf(r * sp[kk]);
            const float u = __builtin_amdgcn_sqrtf(fmaxf(1.f - a * a, 0.f)) * (ig * xcf[tok * 64 + ch]);
            af[tok * 64 + ch] = a;
            xcf[tok * 64 + ch] = u;
          }
        }
      }
    }
    __syncthreads();
    if (gw == 0) {
#pragma unroll 1
      for (int bt = 0; bt < 4; ++bt) {
        float av[8], uv[8];
#pragma unroll
        for (int j = 0; j < 8; ++j) {
          const int tok = dir == 0 ? bt * 8 + j : 31 - (bt * 8 + j);
          av[j] = af[tok * 64 + lane];
          uv[j] = xcf[tok * 64 + lane];
        }
#pragma unroll
        for (int j = 0; j < 8; ++j) {
          h = av[j] * h + uv[j];
          if (dep) {
            pp *= av[j];
            const int tok = dir == 0 ? bt * 8 + j : 31 - (bt * 8 + j);
            pbuf[(size_t)(t0 + c * 32 + tok) * 256 + n * 64 + lane] = pp;
          }
          av[j] = h;
        }
#pragma unroll
        for (int j = 0; j < 8; ++j) {
          const int tok = dir == 0 ? bt * 8 + j : 31 - (bt * 8 + j);
          af[tok * 64 + lane] = av[j];
        }
      }
    }
    __syncthreads();
    {
#pragma unroll
      for (int q = 0; q < 4; ++q) {
        const int idx = gt + 128 * q, tok = idx >> 4, c4 = (idx & 15) * 4;
        const size_t t = (size_t)(t0 + c * 32 + tok);
        const float4 hv = *(const float4*)(af + tok * 64 + c4);
        if (!combine) {
          *(float4*)(yown + t * 256 + n * 64 + c4) = hv;
        } else {
          uint2 ov;
          ov.x = pack2((hv.x + py[q].x) * siluf_(lo2f(pg[q].x)), (hv.y + py[q].y) * siluf_(hi2f(pg[q].x)));
          ov.y = pack2((hv.z + py[q].z) * siluf_(lo2f(pg[q].y)), (hv.w + py[q].w) * siluf_(hi2f(pg[q].y)));
          *(uint2*)(br + t * 1024 + 256 + n * 64 + c4) = ov;
        }
      }
      if (ci + 1 < nch) LRU_WRITE()
    }
  }
  if (gw == 0 && !sample) p.out[O_ST + ((size_t)(b * 2 + l) * 2 + dir) * 256 + n * 64 + lane] = h;
  if (split) {
    float* hend = (float*)(p.ws + WS_HEND) + (size_t)((b * 4 + n) * 2) * 64;
    if (gw == 0 && !dep) hend[dir * 64 + lane] = h;
    asm volatile("s_waitcnt vmcnt(0)" ::: "memory");
    __syncthreads();
    volatile int* sj = (volatile int*)(lds + LDS_BYTES - 16);
    if (threadIdx.x == 0) {
      __builtin_amdgcn_fence(__ATOMIC_RELEASE, "agent");
      asm volatile("s_waitcnt vmcnt(0)" ::: "memory");
      const unsigned old = xb_add((unsigned*)(p.ws + WS_BAR) + XB_JOBCTR(64 + l * 32 + b * 4 + n), 1u);
      if (old == 1u) {
        __builtin_amdgcn_fence(__ATOMIC_ACQUIRE, "agent");
        asm volatile("s_waitcnt vmcnt(0)" ::: "memory");
      }
      sj[2] = (int)old;
    }
    __syncthreads();
    if (sj[2] == 1) {
      const float* yf = (const float*)(p.ws + WS_YF);
      const float* yb = (const float*)(p.ws + WS_YB);
#pragma unroll 4
      for (int idx = tid; idx < 1024 * 16; idx += 256) {
        const int tok = idx >> 4, c4 = (idx & 15) * 4;
        const size_t t = (size_t)(t0 + tok);
        float4 f = *(const float4*)(yf + t * 256 + n * 64 + c4);
        float4 bk = *(const float4*)(yb + t * 256 + n * 64 + c4);
        const float4 pq = *(const float4*)(pbuf + t * 256 + n * 64 + c4);
        const uint2 gv = *(const uint2*)(hin + t * INW + 256 + n * 64 + c4);
        if (tok < 512) {
          const float4 hc = *(const float4*)(hend + 64 + c4);
          bk.x += pq.x * hc.x; bk.y += pq.y * hc.y; bk.z += pq.z * hc.z; bk.w += pq.w * hc.w;
        } else {
          const float4 hc = *(const float4*)(hend + c4);
          f.x += pq.x * hc.x; f.y += pq.y * hc.y; f.z += pq.z * hc.z; f.w += pq.w * hc.w;
        }
        uint2 ov;
        ov.x = pack2((f.x + bk.x) * siluf_(lo2f(gv.x)), (f.y + bk.y) * siluf_(hi2f(gv.x)));
        ov.y = pack2((f.z + bk.z) * siluf_(lo2f(gv.y)), (f.w + bk.w) * siluf_(hi2f(gv.y)));
        *(uint2*)(br + t * 1024 + 256 + n * 64 + c4) = ov;
      }
    }
  }
  __syncthreads();
}

__device__ void phase_mix(const Params& p, int l, unsigned char* lds) {
  const int NATT = 192;
  const int per_list = 16 + (l == 0 ? NATT + 122 : NATT);
  unsigned* ctrs = (unsigned*)(p.ws + WS_BAR) + XB_JOBCTR(128 + l * 8);
  volatile int* sjob = (volatile int*)(lds + LDS_BYTES - 16);
  for (bool first = true;; first = false) {
    const int res = next_tile(ctrs, per_list, first, sjob);
    if (res < 0) break;
    const int x = res / per_list, j = res % per_list;
    if (j < 8) { lru_job(p, l, 16 + x, j >> 1, j & 1, lds); continue; }
    if (j < 16) { const int jj = j - 8; lru_job(p, l, 2 * x + (jj >> 2), jj & 3, -1, lds); continue; }
    int a = j - 16;
    if (l == 0) {
      if (a < 244) {
        if (a & 1) {
          const int gid = x * 122 + (a >> 1);
          for (int q = 0; q < 4; ++q) weight_tile(p, 832 + gid * 4 + q, (float*)lds);
          continue;
        }
        a >>= 1;
      } else {
        a = 122 + (a - 244);
      }
    }
    if (a < 64) {
      attn_job<0, true, 1>(p, l, x, a >> 4, a & 15, lds);
    } else if (a < 96) {
      const int r = a - 64;
      attn_job<3, true, 2>(p, l, x, r >> 3, r & 7, lds);
    } else if (a < 128) {
      const int r = a - 96;
      attn_job<2, true, 2>(p, l, x, r >> 3, r & 7, lds);
    } else if (a < 160) {
      const int r = a - 128;
      attn_job<0, false, 1>(p, l, 2 * x + (r >> 4), (r >> 2) & 3, r & 3, lds);
    } else if (a < 176) {
      const int r = a - 160;
      attn_job<2, false, 2>(p, l, 2 * x + (r >> 3), (r >> 1) & 3, r & 1, lds);
    } else {
      const int r = a - 176;
      attn_job<3, false, 2>(p, l, 2 * x + (r >> 3), (r >> 1) & 3, r & 1, lds);
    }
  }
}

__device__ __forceinline__ unsigned long long rfl64(unsigned long long v) {
  const unsigned lo = __builtin_amdgcn_readfirstlane((unsigned)v), hi = __builtin_amdgcn_readfirstlane((unsigned)(v >> 32));
  return ((unsigned long long)hi << 32) | lo;
}
__device__ __forceinline__ Params get_params(const unsigned long long* sp) {
  Params q;
  q.x_prompt = (const float*)(const float __attribute__((address_space(1)))*)rfl64(sp[0]);
  q.x_sample = (const float*)(const float __attribute__((address_space(1)))*)rfl64(sp[1]);
  q.cdk = (const float*)(const float __attribute__((address_space(1)))*)rfl64(sp[2]);
  q.cdv = (const float*)(const float __attribute__((address_space(1)))*)rfl64(sp[3]);
  q.cnk = (const float*)(const float __attribute__((address_space(1)))*)rfl64(sp[4]);
  q.cnv = (const float*)(const float __attribute__((address_space(1)))*)rfl64(sp[5]);
  q.csk = (const float*)(const float __attribute__((address_space(1)))*)rfl64(sp[6]);
  q.csv = (const float*)(const float __attribute__((address_space(1)))*)rfl64(sp[7]);
  q.state = (const float*)(const float __attribute__((address_space(1)))*)rfl64(sp[8]);
  q.c = (const float*)(const float __attribute__((address_space(1)))*)rfl64(sp[9]);
  q.c_ctx = (const float*)(const float __attribute__((address_space(1)))*)rfl64(sp[10]);
  q.norm_g = (const float*)(const float __attribute__((address_space(1)))*)rfl64(sp[11]);
  q.w_ada = (const float*)(const float __attribute__((address_space(1)))*)rfl64(sp[12]);
  q.b_ada = (const float*)(const float __attribute__((address_space(1)))*)rfl64(sp[13]);
  q.w_in = (const float*)(const float __attribute__((address_space(1)))*)rfl64(sp[14]);
  q.dlam = (const float*)(const float __attribute__((address_space(1)))*)rfl64(sp[15]);
  q.dg = (const float*)(const float __attribute__((address_space(1)))*)rfl64(sp[16]);
  q.conv_w = (const float*)(const float __attribute__((address_space(1)))*)rfl64(sp[17]);
  q.conv_b = (const float*)(const float __attribute__((address_space(1)))*)rfl64(sp[18]);
  q.lru_wa = (const float*)(const float __attribute__((address_space(1)))*)rfl64(sp[19]);
  q.lru_ba = (const float*)(const float __attribute__((address_space(1)))*)rfl64(sp[20]);
  q.lru_wx = (const float*)(const float __attribute__((address_space(1)))*)rfl64(sp[21]);
  q.lru_bx = (const float*)(const float __attribute__((address_space(1)))*)rfl64(sp[22]);
  q.lru_lam = (const float*)(const float __attribute__((address_space(1)))*)rfl64(sp[23]);
  q.rpb = (const float*)(const float __attribute__((address_space(1)))*)rfl64(sp[24]);
  q.sink = (const float*)(const float __attribute__((address_space(1)))*)rfl64(sp[25]);
  q.w_mg = (const float*)(const float __attribute__((address_space(1)))*)rfl64(sp[26]);
  q.b_mg = (const float*)(const float __attribute__((address_space(1)))*)rfl64(sp[27]);
  q.w_bo = (const float*)(const float __attribute__((address_space(1)))*)rfl64(sp[28]);
  q.w_o = (const float*)(const float __attribute__((address_space(1)))*)rfl64(sp[29]);
  q.norm_f = (const float*)(const float __attribute__((address_space(1)))*)rfl64(sp[30]);
  q.out = (float*)(float __attribute__((address_space(1)))*)rfl64(sp[31]);
  q.ws = (unsigned char*)(unsigned char __attribute__((address_space(1)))*)rfl64(sp[32]);
  q.ph_lo = 0;
  q.ph_hi = 12;
  return q;
}

__global__ void __launch_bounds__(256, 2) fwd_megakernel(Params p) {
  __shared__ __attribute__((aligned(16))) unsigned char lds[LDS_BYTES];
  __shared__ uint4 xb_words;
  __shared__ unsigned long long sparams[34];
  cg::grid_group grid = cg::this_grid();
  if (threadIdx.x == 0) {
    xb_words = make_uint4(0u, 0u, 0u, 0u);
    sparams[0] = (unsigned long long)p.x_prompt;
    sparams[1] = (unsigned long long)p.x_sample;
    sparams[2] = (unsigned long long)p.cdk;
    sparams[3] = (unsigned long long)p.cdv;
    sparams[4] = (unsigned long long)p.cnk;
    sparams[5] = (unsigned long long)p.cnv;
    sparams[6] = (unsigned long long)p.csk;
    sparams[7] = (unsigned long long)p.csv;
    sparams[8] = (unsigned long long)p.state;
    sparams[9] = (unsigned long long)p.c;
    sparams[10] = (unsigned long long)p.c_ctx;
    sparams[11] = (unsigned long long)p.norm_g;
    sparams[12] = (unsigned long long)p.w_ada;
    sparams[13] = (unsigned long long)p.b_ada;
    sparams[14] = (unsigned long long)p.w_in;
    sparams[15] = (unsigned long long)p.dlam;
    sparams[16] = (unsigned long long)p.dg;
    sparams[17] = (unsigned long long)p.conv_w;
    sparams[18] = (unsigned long long)p.conv_b;
    sparams[19] = (unsigned long long)p.lru_wa;
    sparams[20] = (unsigned long long)p.lru_ba;
    sparams[21] = (unsigned long long)p.lru_wx;
    sparams[22] = (unsigned long long)p.lru_bx;
    sparams[23] = (unsigned long long)p.lru_lam;
    sparams[24] = (unsigned long long)p.rpb;
    sparams[25] = (unsigned long long)p.sink;
    sparams[26] = (unsigned long long)p.w_mg;
    sparams[27] = (unsigned long long)p.b_mg;
    sparams[28] = (unsigned long long)p.w_bo;
    sparams[29] = (unsigned long long)p.w_o;
    sparams[30] = (unsigned long long)p.norm_f;
    sparams[31] = (unsigned long long)p.out;
    sparams[32] = (unsigned long long)p.ws;
  }
  __syncthreads();
  (void)xcd_barrier_post((unsigned*)(p.ws + WS_BAR), (volatile LAS unsigned*)&xb_words);
  if (p.ph_hi < 0) grid.sync();
#define RUN(PH, CALL)                                  \
  {                                                    \
    const Params q = get_params(sparams);              \
    CALL;                                              \
    if ((PH) + 1 < 12) {                               \
      XcdBarrier xb2;                                  \
      xb2.bar = (unsigned*)((unsigned char*)(unsigned char __attribute__((address_space(1)))*)rfl64(sparams[32]) + WS_BAR); \
      xb2.x = xb_xcc_id();                             \
      xb2.st = (volatile LAS unsigned*)&xb_words;      \
      xcd_barrier(xb2);                                \
    }                                                  \
  }
  RUN(0, phase_prep(q, lds))
#pragma unroll 1
  for (int l = 0; l < 2; ++l) {
    RUN(1 + 5 * l, phase_norm(q, l))
    RUN(2 + 5 * l, phase_gemm1(q, l, lds))
    RUN(3 + 5 * l, phase_mix(q, l, lds))
    RUN(4 + 5 * l, phase_merge(q, l, lds))
    RUN(5 + 5 * l, phase_out(q, l, lds))
  }
  RUN(11, phase_final(q))
}

extern "C" void kernel_launch(void* const* d_in, const int* in_sizes, int n_in, void* d_out, int out_size, void* d_ws,
                              size_t ws_size, hipStream_t stream) {
  static int grid_blocks = 0;
  if (!grid_blocks) {
    int dev = 0, cus = 0, per_cu = 0;
    (void)hipGetDevice(&dev);
    (void)hipDeviceGetAttribute(&cus, hipDeviceAttributeMultiprocessorCount, dev);
    (void)hipOccupancyMaxActiveBlocksPerMultiprocessor(&per_cu, fwd_megakernel, 256, 0);
    if (per_cu < 1) per_cu = 1;
    if (per_cu > 2) per_cu = 2;
    grid_blocks = cus * per_cu;
    if (ws_size < WS_TOTAL) fprintf(stderr, "kernel_launch: workspace too small: %zu < %zu\n", ws_size, (size_t)WS_TOTAL);
  }
  Params p{};
  const float** pp = (const float**)&p;
  for (int i = 0; i < 31; ++i) pp[i] = (const float*)d_in[i];
  p.out = (float*)d_out;
  p.ws = (unsigned char*)d_ws;
  p.ph_lo = 0;
  p.ph_hi = 12;
  (void)hipMemsetAsync((unsigned char*)d_ws + WS_BAR, 0, BAR_TOTAL_WORDS * 4, stream);
  void* args[] = {&p};
  hipError_t e = hipLaunchCooperativeKernel((void*)fwd_megakernel, dim3(grid_blocks), dim3(256), args, 0, stream);
  if (e != hipSuccess) fprintf(stderr, "cooperative launch failed: %s (grid %d)\n", hipGetErrorString(e), grid_blocks);
}
```

```cpp
#include <hip/hip_runtime.h>
#include <hip/hip_cooperative_groups.h>
#include <cstdio>
#include <cstdint>
namespace cg = cooperative_groups;

typedef __attribute__((ext_vector_type(8))) short bf16x8;
typedef __attribute__((ext_vector_type(4))) float f32x4;
typedef unsigned short bf16_t;

#define T_TOK 12288
#define T_PR 4096
#define INW 3328

struct Params {
  const float *x_prompt, *x_sample, *cdk, *cdv, *cnk, *cnv, *csk, *csv, *state, *c, *c_ctx, *norm_g, *w_ada, *b_ada,
      *w_in, *dlam, *dg, *conv_w, *conv_b, *lru_wa, *lru_ba, *lru_wx, *lru_bx, *lru_lam, *rpb, *sink, *w_mg, *b_mg,
      *w_bo, *w_o, *norm_f;
  float* out;
  unsigned char* ws;
  int ph_lo, ph_hi;
};

constexpr size_t WS_WIN = 0;
constexpr size_t WS_WMG = WS_WIN + (size_t)2 * 3328 * 1024 * 2;
constexpr size_t WS_WBO = WS_WMG + (size_t)2 * 4096 * 1024 * 2;
constexpr size_t WS_WO = WS_WBO + (size_t)2 * 4 * 1024 * 256 * 2;
constexpr size_t WS_WLRU = WS_WO + (size_t)2 * 1024 * 1024 * 2;
constexpr size_t WS_MOD = WS_WLRU + (size_t)32 * 4096 * 2;
constexpr size_t WS_CVA = WS_MOD + (size_t)2 * 9 * 3072 * 4;
constexpr size_t WS_CVC = WS_CVA + (size_t)64 * 64 * 512 * 2;
constexpr size_t WS_CVD = WS_CVC + (size_t)64 * 64 * 512 * 2;
constexpr size_t WS_TABA = WS_CVD + (size_t)32 * 64 * 512 * 2;
constexpr size_t WS_TABD = WS_TABA + 64 * 8 * 8;
constexpr size_t WS_H = WS_TABD + 64 * 16 * 8;
constexpr size_t WS_HIN = WS_H + (size_t)T_TOK * 1024 * 2;
constexpr size_t WS_AVT = WS_HIN + (size_t)T_TOK * INW * 2;
constexpr size_t WS_CVT = WS_AVT + (size_t)3145728 * 2;
constexpr size_t WS_DVT = WS_CVT + (size_t)3145728 * 2;
constexpr size_t WS_BR = WS_DVT + (size_t)1572864 * 2;
constexpr size_t WS_YF = WS_BR + (size_t)T_TOK * 1024 * 2;
constexpr size_t WS_YB = WS_YF + (size_t)T_TOK * 256 * 4;
constexpr size_t WS_PB = WS_YB + (size_t)T_TOK * 256 * 4;
constexpr size_t WS_HEND = WS_PB + (size_t)T_TOK * 256 * 4;
constexpr size_t WS_END = WS_HEND + 16384;
constexpr size_t WS_MB = WS_HIN;
constexpr size_t WS_BAR = WS_END;
constexpr size_t WS_TOTAL = WS_BAR + 32768;
static_assert(WS_TOTAL <= (size_t)256 * 1024 * 1024, "workspace map exceeds the guaranteed 256 MiB");

constexpr size_t O_Y = 0;
constexpr size_t O_DK = 12582912;
constexpr size_t O_DV = 14680064;
constexpr size_t O_NK = 16777216;
constexpr size_t O_NV = 18874368;
constexpr size_t O_SK = 20971520;
constexpr size_t O_SV = 22020096;
constexpr size_t O_ST = 23068672;

#define LDS_BYTES 53248

__device__ __forceinline__ int tid_opaque() {
  int t = threadIdx.x;
  asm volatile("" : "+v"(t));
  return t;
}
#define TIDX tid_opaque()
__device__ __forceinline__ unsigned pack2(float a, float b) {
  typedef __attribute__((ext_vector_type(2))) __bf16 bf2_t;
  typedef __attribute__((ext_vector_type(2))) float f2_t;
  f2_t v = {a, b};
  bf2_t r = __builtin_convertvector(v, bf2_t);
  return __builtin_bit_cast(unsigned, r);
}
__device__ __forceinline__ bf16_t f2bf(float f) { return (bf16_t)(pack2(f, 0.f) & 0xffffu); }
__device__ __forceinline__ float bf2f(bf16_t h) { return __uint_as_float(((unsigned)h) << 16); }
__device__ __forceinline__ float lo2f(unsigned u) { return __uint_as_float(u << 16); }
__device__ __forceinline__ float hi2f(unsigned u) { return __uint_as_float(u & 0xffff0000u); }
__device__ __forceinline__ float sigmoidf_(float x) { return __builtin_amdgcn_rcpf(1.f + __builtin_amdgcn_exp2f(-1.4426950408889634f * x)); }
__device__ __forceinline__ float siluf_(float x) { return x * __builtin_amdgcn_rcpf(1.f + __builtin_amdgcn_exp2f(-1.4426950408889634f * x)); }
__device__ __forceinline__ float wave_sum(float v) {
#pragma unroll
  for (int o = 32; o >= 1; o >>= 1) v += __shfl_xor(v, o);
  return v;
}
__device__ __forceinline__ float rowmax4(float x) {
  unsigned u = __float_as_uint(x);
  auto r32 = __builtin_amdgcn_permlane32_swap(u, u, false, false);
  const float m = fmaxf(__uint_as_float(r32[0]), __uint_as_float(r32[1]));
  unsigned v = __float_as_uint(m);
  auto r16 = __builtin_amdgcn_permlane16_swap(v, v, false, false);
  return fmaxf(__uint_as_float(r16[0]), __uint_as_float(r16[1]));
}
__device__ __forceinline__ f32x4 mfma16(bf16x8 a, bf16x8 b, f32x4 c) {
  return __builtin_amdgcn_mfma_f32_16x16x32_bf16(a, b, c, 0, 0, 0);
}
__device__ __forceinline__ const float* xrow(const Params& p, int l, int t) {
  if (l == 0) return t < T_PR ? p.x_prompt + (size_t)t * 1024 : p.x_sample + (size_t)(t - T_PR) * 1024;
  return p.out + O_Y + (size_t)t * 1024;
}


#define XB_TMO      128
#define XB_XCNT(j)  (256  + 64 * (j))
#define XB_XSUB(j)  (1280 + 64 * (j))
#define XB_XGEN(j)  (2304 + 64 * (j))
#define XB_TOP      3328
#define XB_TOPGEN   3392
#define XCD_BAR_WORDS 3456
#define XB_JOBCTR(i) (3456 + 16 * (i))
#define BAR_TOTAL_WORDS (3456 + 16 * 160)
#define XB_SPIN_CAP (1u << 22)
#define LAS __attribute__((address_space(3)))
__device__ __forceinline__ unsigned xb_ld(unsigned* p) { return __hip_atomic_load(p, __ATOMIC_RELAXED, __HIP_MEMORY_SCOPE_AGENT); }
__device__ __forceinline__ unsigned xb_add(unsigned* p, unsigned v) { return __hip_atomic_fetch_add(p, v, __ATOMIC_RELAXED, __HIP_MEMORY_SCOPE_AGENT); }
__device__ __forceinline__ unsigned xb_xcc_id() { return (unsigned)__builtin_amdgcn_s_getreg((3 << 11) | 20) & 0xFu; }
#define XB_SPIN(cond, bar) do { unsigned _sp = 0; while (cond) { __builtin_amdgcn_s_sleep(1); \
    if ((++_sp & 255u) == 0u) { if (xb_ld(&(bar)[XB_TMO])) break; if (_sp > XB_SPIN_CAP) { atomicAdd(&(bar)[XB_TMO], 1u); break; } } } } while (0)
struct XcdBarrier { unsigned* bar; unsigned x; volatile LAS unsigned* st; };
__device__ __forceinline__ XcdBarrier xcd_barrier_post(unsigned* bar, volatile LAS unsigned* st) {
  XcdBarrier b; b.bar = bar; b.x = xb_xcc_id(); b.st = st;
  if (threadIdx.x == 0) (void)xb_add(&bar[XB_XCNT(b.x)], 1u);
  return b;
}
__device__ __forceinline__ void xcd_barrier_complete(unsigned* bar, unsigned x, unsigned& nloc, unsigned& nx) {
  const unsigned G = gridDim.x * gridDim.y * gridDim.z;
  unsigned sum, cnt, mine, sp = 0u;
  for (;;) {
    sum = 0u; cnt = 0u; mine = 0u;
#pragma unroll
    for (unsigned j = 0; j < 16; ++j) { const unsigned c = xb_ld(&bar[XB_XCNT(j)]); sum += c; cnt += (c > 0u) ? 1u : 0u; mine = (j == x) ? c : mine; }
    if (sum == G) break;
    __builtin_amdgcn_s_sleep(1);
    if ((++sp & 255u) == 0u) { if (xb_ld(&bar[XB_TMO])) break; if (sp > XB_SPIN_CAP) { atomicAdd(&bar[XB_TMO], 1u); break; } }
  }
  nloc = mine > 0u ? mine : 1u; nx = cnt > 0u ? cnt : 1u;
}
__device__ __forceinline__ void xcd_barrier(const XcdBarrier& b) {
  asm volatile("s_waitcnt vmcnt(0)" ::: "memory");
  __syncthreads();
  if (threadIdx.x == 0) {
    unsigned* bar = b.bar;
    __builtin_amdgcn_s_waitcnt(0);
    unsigned nloc = b.st[0], nx = b.st[1];
    if (nloc == 0u) { xcd_barrier_complete(bar, b.x, nloc, nx); b.st[0] = nloc; b.st[1] = nx; }
    const unsigned old = xb_add(&bar[XB_XSUB(b.x)], 1u);
    const unsigned gen = old / nloc;
    if (old + 1u == (gen + 1u) * nloc) {
      __builtin_amdgcn_fence(__ATOMIC_RELEASE, "agent");
      asm volatile("s_waitcnt vmcnt(0)" ::: "memory");
      const unsigned og = xb_add(&bar[XB_TOP], 1u);
      const unsigned tg = og / nx;
      if (og + 1u == (tg + 1u) * nx) xb_add(&bar[XB_TOPGEN], 1u);
      else XB_SPIN(xb_ld(&bar[XB_TOPGEN]) == tg, bar);
      __builtin_amdgcn_fence(__ATOMIC_ACQUIRE, "agent");
      xb_add(&bar[XB_XGEN(b.x)], 1u);
      asm volatile("s_waitcnt vmcnt(0)" ::: "memory");
    } else {
      XB_SPIN(xb_ld(&bar[XB_XGEN(b.x)]) == gen, bar);
      __builtin_amdgcn_fence(__ATOMIC_ACQUIRE, "agent");
      asm volatile("s_waitcnt vmcnt(0)" ::: "memory");
    }
  }
  __syncthreads();
}

__device__ void transpose_tile(const float* __restrict__ src, int sld, bf16_t* __restrict__ dst, int dld, float* tile) {
  const int tid = TIDX;
  {
    const int r0 = tid >> 4, c4 = (tid & 15) * 4;
#pragma unroll
    for (int i = 0; i < 4; ++i) {
      const int r = r0 + 16 * i;
      const float4 v = *(const float4*)(src + (size_t)r * sld + c4);
      tile[r * 65 + c4 + 0] = v.x;
      tile[r * 65 + c4 + 1] = v.y;
      tile[r * 65 + c4 + 2] = v.z;
      tile[r * 65 + c4 + 3] = v.w;
    }
  }
  __syncthreads();
  {
    const int r8 = (tid & 7) * 8, c0 = tid >> 3;
#pragma unroll
    for (int i = 0; i < 2; ++i) {
      const int c = c0 + 32 * i;
      uint4 o;
      o.x = pack2(tile[(r8 + 0) * 65 + c], tile[(r8 + 1) * 65 + c]);
      o.y = pack2(tile[(r8 + 2) * 65 + c], tile[(r8 + 3) * 65 + c]);
      o.z = pack2(tile[(r8 + 4) * 65 + c], tile[(r8 + 5) * 65 + c]);
      o.w = pack2(tile[(r8 + 6) * 65 + c], tile[(r8 + 7) * 65 + c]);
      *(uint4*)(dst + (size_t)c * dld + r8) = o;
    }
  }
  __syncthreads();
}

__device__ void weight_tile(const Params& p, int job, float* tile) {
  const int NT_LAYER = 832 + 1024 + 256 + 256;
  {
      int l = job / NT_LAYER, j = job % NT_LAYER;
      if (j < 832) {
        int kt = j / 52, nt = j % 52;
        transpose_tile(p.w_in + (size_t)l * 1024 * 3328 + (size_t)kt * 64 * 3328 + nt * 64, 3328,
                       (bf16_t*)(p.ws + WS_WIN) + (size_t)l * 3328 * 1024 + (size_t)nt * 64 * 1024 + kt * 64, 1024, tile);
      } else if (j < 832 + 1024) {
        j -= 832;
        int kt = j / 64, nt = j % 64;
        transpose_tile(p.w_mg + (size_t)l * 1024 * 4096 + (size_t)kt * 64 * 4096 + nt * 64, 4096,
                       (bf16_t*)(p.ws + WS_WMG) + (size_t)l * 4096 * 1024 + (size_t)nt * 64 * 1024 + kt * 64, 1024, tile);
      } else if (j < 832 + 1024 + 256) {
        j -= 832 + 1024;
        int n = j / 64, r = j % 64, wt = r / 16, mt = r % 16;
        transpose_tile(p.w_bo + ((size_t)(l * 4 + n) * 256 + wt * 64) * 1024 + mt * 64, 1024,
                       (bf16_t*)(p.ws + WS_WBO) + ((size_t)(l * 4 + n) * 1024 + mt * 64) * 256 + wt * 64, 256, tile);
      } else {
        j -= 832 + 1024 + 256;
        int kt = j / 16, nt = j % 16;
        transpose_tile(p.w_o + (size_t)l * 1024 * 1024 + (size_t)kt * 64 * 1024 + nt * 64, 1024,
                       (bf16_t*)(p.ws + WS_WO) + (size_t)l * 1024 * 1024 + (size_t)nt * 64 * 1024 + kt * 64, 1024, tile);
      }
  }
}

__device__ void phase_prep(const Params& p, unsigned char* lds) {
  float* tile = (float*)lds;
  const int NT_LAYER = 832 + 1024 + 256 + 256;
  const int NT_W = 2 * NT_LAYER;
  const int NT_LRU = 32;
  const int NT_CV = 512 + 512 + 256;
  const int NT_ALL = NT_W + NT_LRU + NT_CV;
  const int N_MOD = 384;
  const int NJ = NT_ALL + N_MOD + 1;
  bf16_t* wsb = (bf16_t*)p.ws;
  for (int job = blockIdx.x; job < NJ; job += gridDim.x) {
    if (job < NT_W) {
      if (job < 832) weight_tile(p, job, tile);
    } else if (job < NT_W + NT_LRU) {
      int j = job - NT_W;
      int gate = j & 1, rest = j >> 1;
      transpose_tile((gate ? p.lru_wx : p.lru_wa) + (size_t)rest * 4096, 64, (bf16_t*)(p.ws + WS_WLRU) + (size_t)j * 4096, 64, tile);
    } else if (job < NT_ALL) {
      int j = job - NT_W - NT_LRU;
      if (j < 512) {
        int mat = j >> 3, kt = j & 7;
        transpose_tile(p.cdv + (size_t)mat * 512 * 64 + (size_t)kt * 64 * 64, 64, (bf16_t*)(p.ws + WS_CVA) + (size_t)mat * 64 * 512 + kt * 64, 512, tile);
      } else if (j < 1024) {
        j -= 512;
        int mat = j >> 3, kt = j & 7;
        transpose_tile(p.cnv + (size_t)mat * 512 * 64 + (size_t)kt * 64 * 64, 64, (bf16_t*)(p.ws + WS_CVC) + (size_t)mat * 64 * 512 + kt * 64, 512, tile);
      } else {
        j -= 1024;
        int mat = j >> 3, kt = j & 7;
        transpose_tile(p.csv + (size_t)mat * 512 * 64 + (size_t)kt * 64 * 64, 64, (bf16_t*)(p.ws + WS_CVD) + (size_t)mat * 64 * 512 + kt * 64, 512, tile);
      }
    } else if (job < NT_ALL + N_MOD) {
      int j = job - NT_ALL;
      int l = j / 192, j0 = (j % 192) * 16;
      float* sc = (float*)lds;
      const int tid = TIDX;
      for (int e = tid; e < 9 * 1024; e += 256) {
        int v = e >> 10, k = e & 1023;
        float cvv = v == 0 ? p.c_ctx[k] : p.c[(v - 1) * 1024 + k];
        sc[e] = siluf_(cvv);
      }
      __syncthreads();
      const int jj = tid & 15, ks = tid >> 4;
      float acc[9];
#pragma unroll
      for (int v = 0; v < 9; ++v) acc[v] = 0.f;
      const float* wp = p.w_ada + (size_t)l * 1024 * 3072 + j0 + jj;
#pragma unroll 8
      for (int kk = 0; kk < 64; ++kk) {
        int k = ks * 64 + kk;
        float w = wp[(size_t)k * 3072];
#pragma unroll
        for (int v = 0; v < 9; ++v) acc[v] += sc[v * 1024 + k] * w;
      }
      __syncthreads();
      float* red = (float*)lds;
#pragma unroll
      for (int v = 0; v < 9; ++v) red[(ks * 9 + v) * 16 + jj] = acc[v];
      __syncthreads();
      if (tid < 144) {
        int v = tid >> 4, j2 = tid & 15;
        float s = p.b_ada[(size_t)l * 3072 + j0 + j2];
        for (int q = 0; q < 16; ++q) s += red[(q * 9 + v) * 16 + j2];
        ((float*)(p.ws + WS_MOD))[((size_t)l * 9 + v) * 3072 + j0 + j2] = s;
      }
      __syncthreads();
    } else {
      float2* ta = (float2*)(p.ws + WS_TABA);
      float2* td = (float2*)(p.ws + WS_TABD);
      for (int e = TIDX; e < 64 * 8 + 64 * 16; e += 256) {
        if (e < 512) {
          int pos = e >> 3, i = e & 7;
          float inv = powf(10000.f, -(float)i / 8.f);
          float ang = (float)pos * inv;
          ta[e] = make_float2(cosf(ang), sinf(ang));
        } else {
          int e2 = e - 512;
          int pos = e2 >> 4, i = e2 & 15;
          float inv = powf(10000.f, -(float)i / 16.f);
          float ang = (float)pos * inv;
          td[e2] = make_float2(cosf(ang), sinf(ang));
        }
      }
    }
  }
  (void)wsb;
}

__device__ void phase_norm(const Params& p, int l) {
  const int wave = TIDX >> 6, lane = TIDX & 63;
  const float* modl = (const float*)(p.ws + WS_MOD) + (size_t)l * 9 * 3072;
  bf16_t* hb = (bf16_t*)(p.ws + WS_H);
  const float* gp = p.norm_g + l * 1024;
  for (int t = blockIdx.x * 4 + wave; t < T_TOK; t += gridDim.x * 4) {
    const float* xr = xrow(p, l, t);
    const int v = t < T_PR ? 0 : 1 + ((t - T_PR) >> 10);
    const float* shift = modl + v * 3072;
    const float* scale = shift + 1024;
    float4 xv[4];
    float ss = 0.f;
#pragma unroll
    for (int j = 0; j < 4; ++j) {
      xv[j] = *(const float4*)(xr + j * 256 + lane * 4);
      ss += xv[j].x * xv[j].x + xv[j].y * xv[j].y + xv[j].z * xv[j].z + xv[j].w * xv[j].w;
    }
    ss = wave_sum(ss);
    const float rinv = rsqrtf(ss * (1.f / 1024.f) + 1e-6f);
#pragma unroll
    for (int j = 0; j < 4; ++j) {
      const int c = j * 256 + lane * 4;
      float4 gg = *(const float4*)(gp + c), sc = *(const float4*)(scale + c), sh = *(const float4*)(shift + c);
      float h0 = xv[j].x * rinv * gg.x * (1.f + sc.x) + sh.x;
      float h1 = xv[j].y * rinv * gg.y * (1.f + sc.y) + sh.y;
      float h2 = xv[j].z * rinv * gg.z * (1.f + sc.z) + sh.z;
      float h3 = xv[j].w * rinv * gg.w * (1.f + sc.w) + sh.w;
      uint2 o;
      o.x = pack2(h0, h1);
      o.y = pack2(h2, h3);
      *(uint2*)(hb + (size_t)t * 1024 + c) = o;
    }
  }
}

__device__ void phase_final(const Params& p) {
  const int wave = TIDX >> 6, lane = TIDX & 63;
  for (int t = blockIdx.x * 4 + wave; t < T_TOK; t += gridDim.x * 4) {
    float* xr = p.out + O_Y + (size_t)t * 1024;
    float4 xv[4];
    float ss = 0.f;
#pragma unroll
    for (int j = 0; j < 4; ++j) {
      xv[j] = *(const float4*)(xr + j * 256 + lane * 4);
      ss += xv[j].x * xv[j].x + xv[j].y * xv[j].y + xv[j].z * xv[j].z + xv[j].w * xv[j].w;
    }
    ss = wave_sum(ss);
    const float rinv = rsqrtf(ss * (1.f / 1024.f) + 1e-6f);
#pragma unroll
    for (int j = 0; j < 4; ++j) {
      const int c = j * 256 + lane * 4;
      float4 gg = *(const float4*)(p.norm_f + c);
      float4 o;
      o.x = xv[j].x * rinv * gg.x;
      o.y = xv[j].y * rinv * gg.y;
      o.z = xv[j].z * rinv * gg.z;
      o.w = xv[j].w * rinv * gg.w;
      *(float4*)(xr + c) = o;
    }
  }
}

__device__ __forceinline__ int next_tile(unsigned* ctrs, int per_list, bool first, volatile int* sjob) {
  __syncthreads();
  if (threadIdx.x == 0) {
    int res = -1;
    int cur = first ? 0 : sjob[1];
    const unsigned x = xb_xcc_id();
    while (cur < 8) {
      const int lst = (int)((x + (unsigned)cur) & 7u);
      const int v = (int)xb_add(ctrs + lst * 16, 1u);
      if (v < per_list) { res = lst * per_list + v; break; }
      ++cur;
    }
    sjob[1] = cur;
    sjob[0] = res;
  }
  __syncthreads();
  return sjob[0];
}

#define LDT 80
#define LDV 72
template <int NI, bool FDB = true, bool SWAP = false>
__device__ __forceinline__ void gemm_accum(f32x4 (&acc)[4][NI], const bf16_t* __restrict__ A, int lda,
                                           const bf16_t* __restrict__ Bt, int ldb, int K, bf16_t* As, bf16_t* Bs, int bqrows = 32) {
  const int tid = TIDX, lane = tid & 63, wave = tid >> 6, wm = wave >> 1, wn = wave & 1, g = lane >> 4, c16 = lane & 15;
  const int lr = tid >> 3, lc = (tid & 7) * 8;
  const bf16_t* ap = A + (size_t)lr * lda + lc;
  const bf16_t* bp = Bt + (size_t)lr * ldb + lc;
  const size_t a32 = (size_t)32 * lda, b32 = (size_t)bqrows * ldb;
  uint4 ra0 = *(const uint4*)(ap), ra1 = *(const uint4*)(ap + a32), ra2 = *(const uint4*)(ap + 2 * a32), ra3 = *(const uint4*)(ap + 3 * a32);
  uint4 rb0 = *(const uint4*)(bp), rb1 = *(const uint4*)(bp + b32), rb2, rb3;
  if (NI == 4) { rb2 = *(const uint4*)(bp + 2 * b32); rb3 = *(const uint4*)(bp + 3 * b32); }
  for (int k0 = 0; k0 < K; k0 += 64) {
    *(uint4*)(As + (lr + 0) * LDT + lc) = ra0;
    *(uint4*)(As + (lr + 32) * LDT + lc) = ra1;
    *(uint4*)(As + (lr + 64) * LDT + lc) = ra2;
    *(uint4*)(As + (lr + 96) * LDT + lc) = ra3;
    *(uint4*)(Bs + (lr + 0) * LDT + lc) = rb0;
    *(uint4*)(Bs + (lr + 32) * LDT + lc) = rb1;
    if (NI == 4) {
      *(uint4*)(Bs + (lr + 64) * LDT + lc) = rb2;
      *(uint4*)(Bs + (lr + 96) * LDT + lc) = rb3;
    }
    __syncthreads();
    {
      const int kn = (k0 + 64 < K) ? k0 + 64 : k0;
      ra0 = *(const uint4*)(ap + kn);
      ra1 = *(const uint4*)(ap + a32 + kn);
      ra2 = *(const uint4*)(ap + 2 * a32 + kn);
      ra3 = *(const uint4*)(ap + 3 * a32 + kn);
      rb0 = *(const uint4*)(bp + kn);
      rb1 = *(const uint4*)(bp + b32 + kn);
      if (NI == 4) {
        rb2 = *(const uint4*)(bp + 2 * b32 + kn);
        rb3 = *(const uint4*)(bp + 3 * b32 + kn);
      }
    }
    __builtin_amdgcn_sched_barrier(0);
    if (FDB) {
      bf16x8 af0[4], bf0[NI], af1[4], bf1[NI];
      const bf16_t* arow = As + (wm * 64 + c16) * LDT + g * 8;
      const bf16_t* brow = Bs + (wn * 16 * NI + c16) * LDT + g * 8;
#pragma unroll
      for (int i = 0; i < 4; ++i) af0[i] = *(const bf16x8*)(arow + i * 16 * LDT);
#pragma unroll
      for (int j = 0; j < NI; ++j) bf0[j] = *(const bf16x8*)(brow + j * 16 * LDT);
#pragma unroll
      for (int i = 0; i < 4; ++i) af1[i] = *(const bf16x8*)(arow + i * 16 * LDT + 32);
#pragma unroll
      for (int j = 0; j < NI; ++j) bf1[j] = *(const bf16x8*)(brow + j * 16 * LDT + 32);
      __builtin_amdgcn_sched_barrier(0);
#pragma unroll
      for (int i = 0; i < 4; ++i)
#pragma unroll
        for (int j = 0; j < NI; ++j) acc[i][j] = SWAP ? mfma16(bf0[j], af0[i], acc[i][j]) : mfma16(af0[i], bf0[j], acc[i][j]);
#pragma unroll
      for (int i = 0; i < 4; ++i)
#pragma unroll
        for (int j = 0; j < NI; ++j) acc[i][j] = SWAP ? mfma16(bf1[j], af1[i], acc[i][j]) : mfma16(af1[i], bf1[j], acc[i][j]);
    } else {
#pragma unroll
      for (int ks = 0; ks < 2; ++ks) {
        bf16x8 af[4], bfr[NI];
#pragma unroll
        for (int i = 0; i < 4; ++i) af[i] = *(const bf16x8*)(As + (wm * 64 + i * 16 + c16) * LDT + ks * 32 + g * 8);
#pragma unroll
        for (int j = 0; j < NI; ++j) bfr[j] = *(const bf16x8*)(Bs + (wn * 16 * NI + j * 16 + c16) * LDT + ks * 32 + g * 8);
#pragma unroll
        for (int i = 0; i < 4; ++i)
#pragma unroll
          for (int j = 0; j < NI; ++j) acc[i][j] = SWAP ? mfma16(bfr[j], af[i], acc[i][j]) : mfma16(af[i], bfr[j], acc[i][j]);
      }
    }
    __syncthreads();
  }
}

__device__ void phase_gemm1(const Params& p, int l, unsigned char* lds) {
  bf16_t* As = (bf16_t*)lds;
  bf16_t* Bs = As + 128 * LDT;
  const bf16_t* hb = (const bf16_t*)(p.ws + WS_H);
  const bf16_t* wt = (const bf16_t*)(p.ws + WS_WIN) + (size_t)l * 3328 * 1024;
  bf16_t* hin = (bf16_t*)(p.ws + WS_HIN);
  const float2* tabA = (const float2*)(p.ws + WS_TABA);
  const float2* tabD = (const float2*)(p.ws + WS_TABD);
  const int lane = TIDX & 63, wave = TIDX >> 6, wm = wave >> 1, wn = wave & 1, g = lane >> 4, c16 = lane & 15;
  unsigned* ctrs = (unsigned*)(p.ws + WS_BAR) + XB_JOBCTR(8 + l * 24);
  volatile int* sjob = (volatile int*)(lds + LDS_BYTES - 16);
  for (int tile = blockIdx.x; tile < 96 * 26; tile += gridDim.x) {
    const int rt = tile / 26, ct = tile % 26;
    const int row0 = rt * 128, col0 = ct * 128;
    f32x4 acc[4][4];
#pragma unroll
    for (int i = 0; i < 4; ++i)
#pragma unroll
      for (int j = 0; j < 4; ++j) acc[i][j] = (f32x4){0.f, 0.f, 0.f, 0.f};
    const bool vtile = (col0 >= 1536 && col0 < 1792) || (col0 >= 2560 && col0 < 2816) || col0 >= 3200;
    const int cw = col0 + wn * 64;
    const int rw = row0 + wm * 64;
    const bool sample = row0 >= T_PR;
    int b, pbase, L;
    if (!sample) { b = rw >> 8; pbase = rw & 255; L = 256; }
    else { b = (rw - T_PR) >> 10; pbase = (rw - T_PR) & 1023; L = 1024; }
    if (vtile) {
      gemm_accum<4, true, false>(acc, hb + (size_t)row0 * 1024, 1024, wt + (size_t)col0 * 1024, 1024, 1024, As, Bs);
      int vkind, vhead, vnh = 4;
      if (cw < 1792) { vkind = 0; vhead = (cw - 1536) >> 6; }
      else if (cw < 2816) { vkind = 1; vhead = (cw - 2560) >> 6; }
      else { vkind = 2; vhead = (cw - 3200) >> 6; vnh = 2; }
      bf16_t* vt = (bf16_t*)(p.ws + (vkind == 0 ? WS_AVT : vkind == 1 ? WS_CVT : WS_DVT));
      const size_t base = sample ? (size_t)16 * vnh * 64 * 256 + (size_t)(b * vnh + vhead) * 64 * 1024 : (size_t)(b * vnh + vhead) * 64 * 256;
#pragma unroll
      for (int mi = 0; mi < 4; ++mi)
#pragma unroll
        for (int ni = 0; ni < 4; ++ni) {
          const int d = ni * 16 + c16;
          uint2 o;
          o.x = pack2(acc[mi][ni][0], acc[mi][ni][1]);
          o.y = pack2(acc[mi][ni][2], acc[mi][ni][3]);
          *(uint2*)(vt + base + (size_t)d * L + pbase + mi * 16 + g * 4) = o;
        }
      if (!sample) {
        float* ob = p.out + (vkind == 0 ? O_DV : vkind == 1 ? O_NV : O_SV) + (size_t)((b * 2 + l) * vnh + vhead) * 256 * 64;
#pragma unroll
        for (int mi = 0; mi < 4; ++mi)
#pragma unroll
          for (int i = 0; i < 4; ++i) {
            const int pos = pbase + mi * 16 + g * 4 + i;
#pragma unroll
            for (int ni = 0; ni < 4; ++ni) ob[(size_t)pos * 64 + ni * 16 + c16] = acc[mi][ni][i];
          }
      }
    } else {
      gemm_accum<4, true, true>(acc, hb + (size_t)row0 * 1024, 1024, wt + (size_t)col0 * 1024, 1024, 1024, As, Bs);
      const bool ropeA = sample && cw >= 1024 && cw < 1536;
      const bool ropeD = sample && cw >= 2816 && cw < 3200;
      if (ropeA) {
#pragma unroll
        for (int i = 0; i < 4; ++i) {
          const int pos = pbase + i * 16 + c16;
          const int prow = pos >> 6, pcol = pos & 63;
#pragma unroll
          for (int j = 0; j < 4; ++j)
#pragma unroll
            for (int r = 0; r < 4; ++r) {
              const float2 cs = tabA[((j & 1) ? pcol : prow) * 8 + (g & 1) * 4 + r];
              const float own = acc[i][j][r];
              const float oth = __shfl_xor(own, 32);
              acc[i][j][r] = (g < 2) ? (own * cs.x - oth * cs.y) : (oth * cs.y + own * cs.x);
            }
        }
      } else if (ropeD) {
#pragma unroll
        for (int i = 0; i < 4; ++i) {
          const int pos = pbase + i * 16 + c16;
          const int prow = pos >> 6, pcol = pos & 63;
#pragma unroll
          for (int r = 0; r < 4; ++r) {
            {
              const float2 cs = tabD[prow * 16 + g * 4 + r];
              const float x1 = acc[i][0][r], x2 = acc[i][1][r];
              acc[i][0][r] = x1 * cs.x - x2 * cs.y;
              acc[i][1][r] = x1 * cs.y + x2 * cs.x;
            }
            {
              const float2 cs = tabD[pcol * 16 + g * 4 + r];
              const float x1 = acc[i][2][r], x2 = acc[i][3][r];
              acc[i][2][r] = x1 * cs.x - x2 * cs.y;
              acc[i][3][r] = x1 * cs.y + x2 * cs.x;
            }
          }
        }
      }
#pragma unroll
      for (int i = 0; i < 4; ++i) {
        const size_t r = (size_t)(rw + i * 16 + c16);
#pragma unroll
        for (int j = 0; j < 4; ++j) {
          uint2 o;
          o.x = pack2(acc[i][j][0], acc[i][j][1]);
          o.y = pack2(acc[i][j][2], acc[i][j][3]);
          *(uint2*)(hin + r * INW + cw + j * 16 + g * 4) = o;
        }
      }
      if (!sample) {
        float* ob = nullptr;
        int kind = -1;
        if (cw >= 1280 && cw < 1536) { kind = 0; ob = p.out + O_DK + ((size_t)((b * 2 + l) * 4 + ((cw - 1280) >> 6)) * 2) * 256 * 32; }
        else if (cw >= 2304 && cw < 2560) { kind = 1; ob = p.out + O_NK + (size_t)((b * 2 + l) * 4 + ((cw - 2304) >> 6)) * 256 * 64; }
        else if (cw >= 3072 && cw < 3200) { kind = 1; ob = p.out + O_SK + (size_t)((b * 2 + l) * 2 + ((cw - 3072) >> 6)) * 256 * 64; }
        if (kind == 0) {
#pragma unroll
          for (int i = 0; i < 4; ++i) {
            const int pos = pbase + i * 16 + c16;
#pragma unroll
            for (int j = 0; j < 4; ++j) {
              const float4 o = {acc[i][j][0], acc[i][j][1], acc[i][j][2], acc[i][j][3]};
              *(float4*)(ob + ((size_t)(j >> 1) * 256 + pos) * 32 + (j & 1) * 16 + g * 4) = o;
            }
          }
        } else if (kind == 1) {
#pragma unroll
          for (int i = 0; i < 4; ++i) {
            const int pos = pbase + i * 16 + c16;
#pragma unroll
            for (int j = 0; j < 4; ++j) {
              const float4 o = {acc[i][j][0], acc[i][j][1], acc[i][j][2], acc[i][j][3]};
              *(float4*)(ob + (size_t)pos * 64 + j * 16 + g * 4) = o;
            }
          }
        }
      }
    }
  }
}

__device__ void phase_merge(const Params& p, int l, unsigned char* lds) {
  bf16_t* As = (bf16_t*)lds;
  bf16_t* Bs = As + 128 * LDT;
  const bf16_t* hb = (const bf16_t*)(p.ws + WS_H);
  const bf16_t* br = (const bf16_t*)(p.ws + WS_BR);
  const bf16_t* wmg = (const bf16_t*)(p.ws + WS_WMG) + (size_t)l * 4096 * 1024;
  const bf16_t* wbo = (const bf16_t*)(p.ws + WS_WBO) + (size_t)l * 4 * 1024 * 256;
  bf16_t* mb = (bf16_t*)(p.ws + WS_MB);
  unsigned* ctrs = (unsigned*)(p.ws + WS_BAR) + XB_JOBCTR(16 + l * 24);
  volatile int* sjob = (volatile int*)(lds + LDS_BYTES - 16);
  for (int tile = blockIdx.x; tile < 96 * 8; tile += gridDim.x) {
    const int rt = tile >> 3, ct = tile & 7;
    const int row0 = rt * 128, col0 = ct * 128;
    f32x4 macc[4][4];
#pragma unroll
    for (int i = 0; i < 4; ++i)
#pragma unroll
      for (int j = 0; j < 4; ++j) macc[i][j] = (f32x4){0.f, 0.f, 0.f, 0.f};
#pragma unroll 1
    for (int n = 0; n < 4; ++n) {
      uint2 gp[4][4];
      {
        f32x4 G[4][4];
#pragma unroll
        for (int i = 0; i < 4; ++i)
#pragma unroll
          for (int j = 0; j < 4; ++j) G[i][j] = (f32x4){0.f, 0.f, 0.f, 0.f};
        gemm_accum<4, false, true>(G, hb + (size_t)row0 * 1024, 1024, wmg + (size_t)(n * 1024 + col0) * 1024, 1024, 1024, As, Bs);
        const int lane1 = TIDX & 63, wn1 = (TIDX >> 6) & 1, g1 = lane1 >> 4;
#pragma unroll
        for (int j = 0; j < 4; ++j) {
          const float4 bb = *(const float4*)(p.b_mg + (size_t)l * 4096 + n * 1024 + col0 + wn1 * 64 + j * 16 + g1 * 4);
#pragma unroll
          for (int i = 0; i < 4; ++i) {
            gp[i][j].x = pack2(sigmoidf_(G[i][j][0] + bb.x), sigmoidf_(G[i][j][1] + bb.y));
            gp[i][j].y = pack2(sigmoidf_(G[i][j][2] + bb.z), sigmoidf_(G[i][j][3] + bb.w));
          }
        }
      }
#pragma unroll
      for (int hh = 0; hh < 2; ++hh) {
        f32x4 Pa[4][2];
#pragma unroll
        for (int i = 0; i < 4; ++i)
#pragma unroll
          for (int j = 0; j < 2; ++j) Pa[i][j] = (f32x4){0.f, 0.f, 0.f, 0.f};
        gemm_accum<2, true, true>(Pa, br + (size_t)row0 * 1024 + n * 256, 1024, wbo + (size_t)(n * 1024 + col0 + hh * 32) * 256, 256, 256, As, Bs, 64);
#pragma unroll
        for (int i = 0; i < 4; ++i)
#pragma unroll
          for (int j = 0; j < 2; ++j) {
            macc[i][hh * 2 + j][0] += lo2f(gp[i][hh * 2 + j].x) * Pa[i][j][0];
            macc[i][hh * 2 + j][1] += hi2f(gp[i][hh * 2 + j].x) * Pa[i][j][1];
            macc[i][hh * 2 + j][2] += lo2f(gp[i][hh * 2 + j].y) * Pa[i][j][2];
            macc[i][hh * 2 + j][3] += hi2f(gp[i][hh * 2 + j].y) * Pa[i][j][3];
          }
      }
    }
    const int lane = TIDX & 63, wave = TIDX >> 6, wm = wave >> 1, wn = wave & 1, g = lane >> 4, c16 = lane & 15;
#pragma unroll
    for (int i = 0; i < 4; ++i) {
      const size_t r = (size_t)(row0 + wm * 64 + i * 16 + c16);
#pragma unroll
      for (int j = 0; j < 4; ++j) {
        uint2 o;
        o.x = pack2(macc[i][j][0], macc[i][j][1]);
        o.y = pack2(macc[i][j][2], macc[i][j][3]);
        *(uint2*)(mb + r * 1024 + col0 + wn * 64 + j * 16 + g * 4) = o;
      }
    }
  }
}

__device__ void phase_out(const Params& p, int l, unsigned char* lds) {
  bf16_t* As = (bf16_t*)lds;
  bf16_t* Bs = As + 128 * LDT;
  const bf16_t* mb = (const bf16_t*)(p.ws + WS_MB);
  const bf16_t* wo = (const bf16_t*)(p.ws + WS_WO) + (size_t)l * 1024 * 1024;
  const float* modl = (const float*)(p.ws + WS_MOD) + (size_t)l * 9 * 3072;
  const int lane = TIDX & 63, wave = TIDX >> 6, wm = wave >> 1, wn = wave & 1, g = lane >> 4, c16 = lane & 15;
  unsigned* ctrs = (unsigned*)(p.ws + WS_BAR) + XB_JOBCTR(24 + l * 24);
  volatile int* sjob = (volatile int*)(lds + LDS_BYTES - 16);
  for (int tile = blockIdx.x; tile < 96 * 8; tile += gridDim.x) {
    const int rt = tile >> 3, ct = tile & 7;
    const int row0 = rt * 128, col0 = ct * 128;
    f32x4 acc[4][4];
#pragma unroll
    for (int i = 0; i < 4; ++i)
#pragma unroll
      for (int j = 0; j < 4; ++j) acc[i][j] = (f32x4){0.f, 0.f, 0.f, 0.f};
    gemm_accum<4, true, true>(acc, mb + (size_t)row0 * 1024, 1024, wo + (size_t)col0 * 1024, 1024, 1024, As, Bs);
    const int v = row0 < T_PR ? 0 : 1 + ((row0 - T_PR) >> 10);
    const float* gate = modl + v * 3072 + 2048;
#pragma unroll
    for (int j = 0; j < 4; ++j) {
      const int col = col0 + wn * 64 + j * 16 + g * 4;
      const float4 gt = *(const float4*)(gate + col);
#pragma unroll
      for (int i = 0; i < 4; ++i) {
        const int t = row0 + wm * 64 + i * 16 + c16;
        const float4 xo = *(const float4*)(xrow(p, l, t) + col);
        float4 o;
        o.x = xo.x + gt.x * acc[i][j][0];
        o.y = xo.y + gt.y * acc[i][j][1];
        o.z = xo.z + gt.z * acc[i][j][2];
        o.w = xo.w + gt.w * acc[i][j][3];
        *(float4*)(p.out + O_Y + (size_t)t * 1024 + col) = o;
      }
    }
  }
}

template <int NM, int MODE>
__device__ __forceinline__ void attn_chunk(const bf16_t* Ks, const bf16_t* Vts, int koff, const bf16x8 (&qf)[2], float scale,
                                           float (&m_run)[NM], float (&l_run)[NM], f32x4 (&o)[NM][4], int lane,
                                           int qa, int qb, int ka, const float* rpbh) {
  const int g = lane >> 4, r16 = lane & 15;
  f32x4 s[NM][2];
#pragma unroll
  for (int kt = 0; kt < 2; ++kt) {
    const bf16_t* kp = Ks + (koff + kt * 16 + r16) * LDT + g * 8;
    const bf16x8 k0 = *(const bf16x8*)kp;
    const bf16x8 k1 = *(const bf16x8*)(kp + 32);
    const f32x4 z = {0.f, 0.f, 0.f, 0.f};
    if (NM == 2) {
      s[0][kt] = mfma16(k0, qf[0], z);
      s[NM - 1][kt] = mfma16(k1, qf[1], z);
    } else {
      s[0][kt] = mfma16(k1, qf[1], mfma16(k0, qf[0], z));
    }
  }
  bool valid[2][4];
  float bias[2][4];
#pragma unroll
  for (int kt = 0; kt < 2; ++kt)
#pragma unroll
    for (int i = 0; i < 4; ++i) {
      valid[kt][i] = true;
      bias[kt][i] = 0.f;
      const int kk = koff + kt * 16 + g * 4 + i;
      if (MODE == 1) {
        int cs = qb - 8;
        cs = cs < 0 ? 0 : (cs > 48 ? 48 : cs);
        const bool ok = (kk >= cs) && (kk < cs + 16);
        valid[kt][i] = ok;
        int dc = kk - qb + 15;
        dc = dc < 0 ? 0 : (dc > 30 ? 30 : dc);
        bias[kt][i] = rpbh[(ka - qa + 7) * 31 + dc] * 1.4426950408889634f;
      } else if (MODE == 2) {
        const int kp = ka + kt * 16 + g * 4 + i;
        int df = qa - kp;
        df = df < 0 ? -df : df;
        valid[kt][i] = df <= 128;
      }
    }
  bf16x8 pb[NM];
#pragma unroll
  for (int m = 0; m < NM; ++m) {
    float x[2][4];
    float mx = -1e30f;
#pragma unroll
    for (int kt = 0; kt < 2; ++kt)
#pragma unroll
      for (int i = 0; i < 4; ++i) {
        float xv = MODE == 1 ? fmaf(s[m][kt][i], scale, bias[kt][i]) : s[m][kt][i] * scale;
        if (MODE != 0) xv = valid[kt][i] ? xv : -1e30f;
        x[kt][i] = xv;
        mx = fmaxf(mx, xv);
      }
    mx = rowmax4(mx);
    const float mn = fmaxf(m_run[m], mx);
    const float alpha = __builtin_amdgcn_exp2f(m_run[m] - mn);
    m_run[m] = mn;
    float ps = 0.f;
    float pv[8];
#pragma unroll
    for (int kt = 0; kt < 2; ++kt)
#pragma unroll
      for (int i = 0; i < 4; ++i) {
        float e = __builtin_amdgcn_exp2f(x[kt][i] - mn);
        if (MODE != 0) e = valid[kt][i] ? e : 0.f;
        pv[kt * 4 + i] = e;
        ps += e;
      }
    l_run[m] = l_run[m] * alpha + ps;
#pragma unroll
    for (int dt = 0; dt < 4; ++dt) {
      o[m][dt][0] *= alpha;
      o[m][dt][1] *= alpha;
      o[m][dt][2] *= alpha;
      o[m][dt][3] *= alpha;
    }
    union { bf16x8 v; unsigned u[4]; } pk;
    pk.u[0] = pack2(pv[0], pv[1]);
    pk.u[1] = pack2(pv[2], pv[3]);
    pk.u[2] = pack2(pv[4], pv[5]);
    pk.u[3] = pack2(pv[6], pv[7]);
    pb[m] = pk.v;
  }
#pragma unroll
  for (int dt = 0; dt < 4; ++dt) {
    const bf16_t* vp = Vts + (dt * 16 + r16) * LDV + koff + g * 4;
    union { bf16x8 v; uint2 u[2]; } vf;
    vf.u[0] = *(const uint2*)vp;
    vf.u[1] = *(const uint2*)(vp + 16);
#pragma unroll
    for (int m = 0; m < NM; ++m) o[m][dt] = mfma16(vf.v, pb[m], o[m][dt]);
  }
}

template <int NM, int MODE>
__device__ __forceinline__ void attn_tile64(const bf16_t* Ks, const bf16_t* Vts, const bf16x8 (&qf)[2],
                                            float (&m_run)[NM], float (&l_run)[NM], f32x4 (&o)[NM][4], int lane, int qa, int ka,
                                            bool first) {
  const int g = lane >> 4, r16 = lane & 15;
  f32x4 s[NM][4];
  f32x4 ci[NM];
#pragma unroll
  for (int m = 0; m < NM; ++m) {
    const float c = first ? 0.f : -m_run[m];
    ci[m] = (f32x4){c, c, c, c};
  }
#pragma unroll
  for (int kt = 0; kt < 4; ++kt) {
    const bf16_t* kp = Ks + (kt * 16 + r16) * LDT + g * 8;
    const bf16x8 k0 = *(const bf16x8*)kp;
    const bf16x8 k1 = *(const bf16x8*)(kp + 32);
    if (NM == 2) {
      s[0][kt] = mfma16(k0, qf[0], ci[0]);
      s[NM - 1][kt] = mfma16(k1, qf[1], ci[NM - 1]);
    } else {
      s[0][kt] = mfma16(k1, qf[1], mfma16(k0, qf[0], ci[0]));
    }
  }
  if (MODE == 2) {
#pragma unroll
    for (int kt = 0; kt < 4; ++kt)
#pragma unroll
      for (int i = 0; i < 4; ++i) {
        int df = qa - (ka + kt * 16 + g * 4 + i);
        df = df < 0 ? -df : df;
        const bool ok = df <= 128;
#pragma unroll
        for (int m = 0; m < NM; ++m) s[m][kt][i] = ok ? s[m][kt][i] : -1e30f;
      }
  }
  bf16x8 pbA[NM], pbB[NM];
#pragma unroll
  for (int m = 0; m < NM; ++m) {
    float mx = fmaxf(fmaxf(fmaxf(s[m][0][0], s[m][0][1]), fmaxf(s[m][0][2], s[m][0][3])),
                     fmaxf(fmaxf(s[m][1][0], s[m][1][1]), fmaxf(s[m][1][2], s[m][1][3])));
    mx = fmaxf(mx, fmaxf(fmaxf(fmaxf(s[m][2][0], s[m][2][1]), fmaxf(s[m][2][2], s[m][2][3])),
                         fmaxf(fmaxf(s[m][3][0], s[m][3][1]), fmaxf(s[m][3][2], s[m][3][3]))));
    mx = rowmax4(mx);
    if (first || __any(mx > 0.f)) {
      const float d = first ? mx : fmaxf(mx, 0.f);
      const float alpha = first ? 0.f : __builtin_amdgcn_exp2f(-d);
      m_run[m] = first ? d : m_run[m] + d;
      l_run[m] *= alpha;
#pragma unroll
      for (int dt = 0; dt < 4; ++dt) o[m][dt] *= alpha;
#pragma unroll
      for (int kt = 0; kt < 4; ++kt) s[m][kt] -= d;
    }
    f32x4 ps4 = {0.f, 0.f, 0.f, 0.f};
#pragma unroll
    for (int kt = 0; kt < 4; ++kt) {
      s[m][kt][0] = __builtin_amdgcn_exp2f(s[m][kt][0]);
      s[m][kt][1] = __builtin_amdgcn_exp2f(s[m][kt][1]);
      s[m][kt][2] = __builtin_amdgcn_exp2f(s[m][kt][2]);
      s[m][kt][3] = __builtin_amdgcn_exp2f(s[m][kt][3]);
      ps4 += s[m][kt];
    }
    l_run[m] += (ps4[0] + ps4[1]) + (ps4[2] + ps4[3]);
    union { bf16x8 v; unsigned u[4]; } pk;
    pk.u[0] = pack2(s[m][0][0], s[m][0][1]);
    pk.u[1] = pack2(s[m][0][2], s[m][0][3]);
    pk.u[2] = pack2(s[m][1][0], s[m][1][1]);
    pk.u[3] = pack2(s[m][1][2], s[m][1][3]);
    pbA[m] = pk.v;
    pk.u[0] = pack2(s[m][2][0], s[m][2][1]);
    pk.u[1] = pack2(s[m][2][2], s[m][2][3]);
    pk.u[2] = pack2(s[m][3][0], s[m][3][1]);
    pk.u[3] = pack2(s[m][3][2], s[m][3][3]);
    pbB[m] = pk.v;
  }
#pragma unroll
  for (int dt = 0; dt < 4; ++dt) {
    const bf16_t* vp = Vts + (dt * 16 + r16) * LDV + g * 4;
    union { bf16x8 v; uint2 u[2]; } vfA, vfB;
    vfA.u[0] = *(const uint2*)vp;
    vfA.u[1] = *(const uint2*)(vp + 16);
    vfB.u[0] = *(const uint2*)(vp + 32);
    vfB.u[1] = *(const uint2*)(vp + 48);
#pragma unroll
    for (int m = 0; m < NM; ++m) {
      o[m][dt] = mfma16(vfA.v, pbA[m], o[m][dt]);
      o[m][dt] = mfma16(vfB.v, pbB[m], o[m][dt]);
    }
  }
}

template <int BR, bool SAMPLE, int QG>
__device__ void attn_job(const Params& p, int l, int b, int head, int qp, unsigned char* lds) {
  constexpr int L = SAMPLE ? 1024 : 256;
  constexpr int NM = BR == 0 ? 2 : 1;
  constexpr int QCOL = BR == 0 ? 1024 : (BR == 2 ? 2048 : 2816);
  constexpr int KCOL = BR == 0 ? 1280 : (BR == 2 ? 2304 : 3072);
  constexpr int GCOL = BR == 0 ? 0 : (BR == 2 ? 512 : 768);
  constexpr int NKH = BR == 3 ? 2 : 4;
  bf16_t* Ks = (bf16_t*)lds;
  bf16_t* Vts = Ks + 64 * LDT;
  const int tid = TIDX, lane = tid & 63, w = tid >> 6, g = lane >> 4, qi = lane & 15;
  const int t0 = SAMPLE ? T_PR + b * 1024 : b * 256;
  int qpos[QG], tq[QG];
#pragma unroll
  for (int gq = 0; gq < QG; ++gq) {
    qpos[gq] = (QG * qp + gq) * 64 + w * 16 + qi;
    tq[gq] = t0 + qpos[gq];
  }
  const bf16_t* hin = (const bf16_t*)(p.ws + WS_HIN);
  const int kvh = BR == 3 ? (head >> 1) : head;
  const int kcol = KCOL + kvh * 64;
  const bf16_t* vT = (const bf16_t*)(p.ws + (BR == 0 ? WS_AVT : (BR == 2 ? WS_CVT : WS_DVT))) +
                     (SAMPLE ? (size_t)16 * NKH * 64 * 256 + (size_t)(b * NKH + kvh) * 64 * 1024 : (size_t)(b * NKH + kvh) * 64 * 256);
  const int cmat = (b * 2 + l) * NKH + kvh;
  const bf16_t* cvt = (const bf16_t*)(p.ws + (BR == 0 ? WS_CVA : (BR == 2 ? WS_CVC : WS_CVD))) + (size_t)cmat * 64 * 512;
  bf16x8 qf[QG][2];
  float m_run[QG][NM], l_run[QG][NM];
  f32x4 o[QG][NM][4];
#pragma unroll
  for (int gq = 0; gq < QG; ++gq) {
    qf[gq][0] = *(const bf16x8*)(hin + (size_t)tq[gq] * INW + QCOL + head * 64 + g * 8);
    qf[gq][1] = *(const bf16x8*)(hin + (size_t)tq[gq] * INW + QCOL + head * 64 + 32 + g * 8);
    const float qs = (BR == 0 ? 0.17677669529663687f : 0.125f) * 1.4426950408889634f;
#pragma unroll
    for (int i = 0; i < 2; ++i) {
      union { bf16x8 v; unsigned u[4]; } t;
      t.v = qf[gq][i];
#pragma unroll
      for (int w2 = 0; w2 < 4; ++w2) t.u[w2] = pack2(lo2f(t.u[w2]) * qs, hi2f(t.u[w2]) * qs);
      qf[gq][i] = t.v;
    }
#pragma unroll
    for (int m = 0; m < NM; ++m) {
      m_run[gq][m] = -1e30f;
      l_run[gq][m] = 0.f;
#pragma unroll
      for (int dt = 0; dt < 4; ++dt) o[gq][m][dt] = (f32x4){0.f, 0.f, 0.f, 0.f};
    }
    if (BR == 3) {
      m_run[gq][0] = p.sink[l * 4 + head] * 1.4426950408889634f;
      l_run[gq][0] = (g == 0) ? 1.f : 0.f;
    }
  }
  const float scale = 1.f;
  const int nctx = SAMPLE ? 8 : 0;
  int loc0 = 0, nloc = 4;
  int glo[QG], ghi[QG];
#pragma unroll
  for (int gq = 0; gq < QG; ++gq) { glo[gq] = 0; ghi[gq] = 3; }
  if (SAMPLE) {
#pragma unroll
    for (int gq = 0; gq < QG; ++gq) {
      const int qtg = QG * qp + gq;
      if (BR == 0) { glo[gq] = 0; ghi[gq] = 15; }
      else if (BR == 2) { int rs = qtg - 4; rs = rs < 0 ? 0 : (rs > 8 ? 8 : rs); glo[gq] = rs; ghi[gq] = rs + 7; }
      else { glo[gq] = qtg - 2 < 0 ? 0 : qtg - 2; ghi[gq] = qtg + 2 > 15 ? 15 : qtg + 2; }
    }
    loc0 = glo[0];
    nloc = ghi[QG - 1] - glo[0] + 1;
  }
  const float* rpbh = p.rpb + (size_t)(l * 4 + head) * 15 * 31;
  const int nb = w * 16 - 8;
  const int boff = nb < 0 ? 0 : (nb > 32 ? 32 : nb);
  const int ntl = nctx + nloc;
  const int skey = tid >> 2, sseg = tid & 3;
  float4 kr0 = make_float4(0.f, 0.f, 0.f, 0.f), kr1 = kr0, kr2 = kr0, kr3 = kr0;
  uint4 vr0, vr1;
#define ATT_ISSUE(IT2)                                                                                                   \
  {                                                                                                                      \
    const int it2_ = (IT2);                                                                                              \
    const bool c2 = it2_ < nctx;                                                                                         \
    const int kt2 = c2 ? it2_ : loc0 + (it2_ - nctx);                                                                    \
    if (c2) {                                                                                                            \
      const float* src;                                                                                                  \
      if (BR == 0) src = p.cdk + ((((size_t)(b * 2 + l) * 4 + head) * 2 + (sseg >> 1)) * 512 + kt2 * 64 + skey) * 32 + (sseg & 1) * 16; \
      else if (BR == 2) src = p.cnk + (((size_t)(b * 2 + l) * 4 + head) * 512 + kt2 * 64 + skey) * 64 + sseg * 16;      \
      else src = p.csk + (((size_t)(b * 2 + l) * 2 + kvh) * 512 + kt2 * 64 + skey) * 64 + sseg * 16;                     \
      kr0 = ((const float4*)src)[0];                                                                                     \
      kr1 = ((const float4*)src)[1];                                                                                     \
      kr2 = ((const float4*)src)[2];                                                                                     \
      kr3 = ((const float4*)src)[3];                                                                                     \
    } else {                                                                                                             \
      const bf16_t* src = hin + (size_t)(t0 + kt2 * 64 + skey) * INW + kcol + sseg * 16;                                 \
      kr0 = ((const float4*)src)[0];                                                                                     \
      kr1 = ((const float4*)src)[1];                                                                                     \
    }                                                                                                                    \
    const bf16_t* vsrc = c2 ? cvt + (size_t)skey * 512 + kt2 * 64 + sseg * 16 : vT + (size_t)skey * L + kt2 * 64 + sseg * 16; \
    vr0 = ((const uint4*)vsrc)[0];                                                                                       \
    vr1 = ((const uint4*)vsrc)[1];                                                                                       \
  }
#define ATT_WRITE(CTX, KB, VB)                                                                                        \
  {                                                                                                                      \
    uint4 u0, u1;                                                                                                        \
    if (CTX) {                                                                                                           \
      u0.x = pack2(kr0.x, kr0.y); u0.y = pack2(kr0.z, kr0.w); u0.z = pack2(kr1.x, kr1.y); u0.w = pack2(kr1.z, kr1.w);    \
      u1.x = pack2(kr2.x, kr2.y); u1.y = pack2(kr2.z, kr2.w); u1.z = pack2(kr3.x, kr3.y); u1.w = pack2(kr3.z, kr3.w);    \
    } else {                                                                                                             \
      u0 = __builtin_bit_cast(uint4, kr0);                                                                               \
      u1 = __builtin_bit_cast(uint4, kr1);                                                                               \
    }                                                                                                                    \
    *(uint4*)((KB) + skey * LDT + sseg * 16) = u0;                                                                       \
    *(uint4*)((KB) + skey * LDT + sseg * 16 + 8) = u1;                                                                   \
    *(uint4*)((VB) + skey * LDV + sseg * 16) = vr0;                                                                      \
    *(uint4*)((VB) + skey * LDV + sseg * 16 + 8) = vr1;                                                                  \
  }
  constexpr int KVB = 64 * LDT + 64 * LDV;
  __syncthreads();
  ATT_ISSUE(0)
  ATT_WRITE(0 < nctx, Ks, Vts)
  if (1 < ntl) ATT_ISSUE(1)
  __syncthreads();
  for (int it = 0; it < ntl; ++it) {
    const bool isctx = it < nctx;
    const int kt = isctx ? it : loc0 + (it - nctx);
    const bf16_t* Kc = Ks + (it & 1) * KVB;
    const bf16_t* Vc = Vts + (it & 1) * KVB;
    if (it + 1 < ntl) ATT_WRITE(it + 1 < nctx, Ks + ((it + 1) & 1) * KVB, Vts + ((it + 1) & 1) * KVB)
    if (it + 2 < ntl) ATT_ISSUE(it + 2)
    __builtin_amdgcn_sched_barrier(0);
#pragma unroll
    for (int gq = 0; gq < QG; ++gq) {
      if (!isctx && (kt < glo[gq] || kt > ghi[gq])) continue;
      if (SAMPLE && BR == 2 && !isctx) {
        attn_chunk<NM, 1>(Kc, Vc, boff, qf[gq], scale, m_run[gq], l_run[gq], o[gq], lane, QG * qp + gq, w * 16 + qi, kt, rpbh);
      } else if (SAMPLE && BR == 3 && !isctx) {
        attn_tile64<NM, 2>(Kc, Vc, qf[gq], m_run[gq], l_run[gq], o[gq], lane, qpos[gq], kt * 64, false);
      } else {
        attn_tile64<NM, 0>(Kc, Vc, qf[gq], m_run[gq], l_run[gq], o[gq], lane, 0, 0, BR != 3 && it == 0);
      }
    }
    __syncthreads();
  }
#undef ATT_WRITE
  float lam = 0.f, lam_init = 0.f;
  if (BR == 0) {
    float s01 = 0.f, s23 = 0.f;
    for (int e = 0; e < 32; ++e) {
      s01 += p.dlam[l * 128 + e] * p.dlam[l * 128 + 32 + e];
      s23 += p.dlam[l * 128 + 64 + e] * p.dlam[l * 128 + 96 + e];
    }
    lam_init = 0.8f - 0.6f * expf(-0.3f * (float)l);
    lam = expf(s01) - expf(s23) + lam_init;
  }
  bf16_t* br = (bf16_t*)(p.ws + WS_BR);
#pragma unroll
  for (int gq = 0; gq < QG; ++gq) {
    float linv[NM];
#pragma unroll
    for (int m = 0; m < NM; ++m) {
      float lt = l_run[gq][m];
      lt += __shfl_xor(lt, 16);
      lt += __shfl_xor(lt, 32);
      linv[m] = 1.f / lt;
    }
    float y[4][4];
    if (BR == 0) {
      float ss = 0.f;
#pragma unroll
      for (int dt = 0; dt < 4; ++dt)
#pragma unroll
        for (int i = 0; i < 4; ++i) {
          float v = o[gq][0][dt][i] * linv[0] - lam * (o[gq][NM - 1][dt][i] * linv[NM - 1]);
          y[dt][i] = v;
          ss += v * v;
        }
      ss += __shfl_xor(ss, 16);
      ss += __shfl_xor(ss, 32);
      const float rinv = rsqrtf(ss * (1.f / 64.f) + 1e-6f) * (1.f - lam_init);
#pragma unroll
      for (int dt = 0; dt < 4; ++dt)
#pragma unroll
        for (int i = 0; i < 4; ++i) y[dt][i] *= rinv * p.dg[l * 64 + dt * 16 + g * 4 + i];
    } else {
#pragma unroll
      for (int dt = 0; dt < 4; ++dt)
#pragma unroll
        for (int i = 0; i < 4; ++i) y[dt][i] = o[gq][0][dt][i] * linv[0];
    }
#pragma unroll
    for (int dt = 0; dt < 4; ++dt) {
      const int d = dt * 16 + g * 4;
      const uint2 gv = *(const uint2*)(hin + (size_t)tq[gq] * INW + GCOL + head * 64 + d);
      uint2 ov;
      ov.x = pack2(y[dt][0] * siluf_(lo2f(gv.x)), y[dt][1] * siluf_(hi2f(gv.x)));
      ov.y = pack2(y[dt][2] * siluf_(lo2f(gv.y)), y[dt][3] * siluf_(hi2f(gv.y)));
      *(uint2*)(br + (size_t)tq[gq] * 1024 + GCOL + head * 64 + d) = ov;
    }
  }
}

__device__ void lru_job(const Params& p, int l, int seq, int n, int half, unsigned char* lds) {
  const bool sample = seq >= 16;
  const int b = sample ? seq - 16 : seq;
  const int L = sample ? 1024 : 256;
  const int t0 = sample ? T_PR + b * 1024 : b * 256;
  const int tid = TIDX, dir = tid >> 7, gt = tid & 127, gw = (tid >> 6) & 1, lane = tid & 63, g = lane >> 4, c16 = lane & 15;
  unsigned char* base = lds + dir * 26112;
  bf16_t* bxs = (bf16_t*)base;
  bf16_t* xcb = (bf16_t*)(base + 4480);
  float* xcf = (float*)(base + 4480 + 5120);
  float* af = (float*)(base + 4480 + 5120 + 8192);
  const bf16_t* hin = (const bf16_t*)(p.ws + WS_HIN);
  const bf16_t* wl = (const bf16_t*)(p.ws + WS_WLRU) + (size_t)(((l * 2 + dir) * 4 + n) * 2) * 4096;
  bf16x8 wf[2][2][2];
#pragma unroll
  for (int gate = 0; gate < 2; ++gate)
#pragma unroll
    for (int kk = 0; kk < 2; ++kk)
#pragma unroll
      for (int ks = 0; ks < 2; ++ks)
        wf[gate][kk][ks] = *(const bf16x8*)(wl + (size_t)gate * 4096 + ((2 * gw + kk) * 16 + c16) * 64 + ks * 32 + g * 8);
  float ba[2], bx[2], sp[2];
#pragma unroll
  for (int kk = 0; kk < 2; ++kk) {
    const int ch = n * 64 + (2 * gw + kk) * 16 + c16;
    ba[kk] = p.lru_ba[(l * 2 + dir) * 256 + ch];
    bx[kk] = p.lru_bx[(l * 2 + dir) * 256 + ch];
    const float lm = p.lru_lam[(l * 2 + dir) * 256 + ch];
    sp[kk] = -8.f * log1pf(expf(-lm));
  }
  const int cch = n * 64 + lane;
  const float cw0 = p.conv_w[(l * 4 + 0) * 256 + cch], cw1 = p.conv_w[(l * 4 + 1) * 256 + cch], cw2 = p.conv_w[(l * 4 + 2) * 256 + cch],
              cw3 = p.conv_w[(l * 4 + 3) * 256 + cch], cb = p.conv_b[l * 256 + cch];
  const bool split = half >= 0;
  const bool dep = split && (dir == 0 ? half == 1 : half == 0);
  float h = 0.f, pp = 1.f;
  if (sample && !dep) h = p.state[((size_t)(b * 2 + l) * 2 + dir) * 256 + n * 64 + lane];
  float* pbuf = (float*)(p.ws + WS_PB);
  float* yown = (float*)(p.ws + (dir == 0 ? WS_YF : WS_YB));
  const float* yoth = (const float*)(p.ws + (dir == 0 ? WS_YB : WS_YF));
  bf16_t* br = (bf16_t*)(p.ws + WS_BR);
  const int nch = split ? 16 : L / 32;
  const int c_lo = split ? half * 16 : 0;
  uint4 rw0, rw1, rw2;
#define LRU_ISSUE(CC)                                                                                               \
  {                                                                                                                    \
    const int cc_ = (CC);                                                                                              \
    {                                                                                                                  \
      const int idx = gt, r = idx >> 3, sg = idx & 7, pos = cc_ * 32 - 1 + r;                                          \
      const bool ok = pos >= 0 && pos < L;                                                                             \
      const int pc = ok ? pos : 0;                                                                                     \
      uint4 v = *(const uint4*)(hin + (size_t)(t0 + pc) * INW + 1792 + n * 64 + sg * 8);                               \
      rw0.x = ok ? v.x : 0u; rw0.y = ok ? v.y : 0u; rw0.z = ok ? v.z : 0u; rw0.w = ok ? v.w : 0u;                      \
    }                                                                                                                  \
    {                                                                                                                  \
      const int idx = gt + 128, r = idx >> 3, sg = idx & 7, pos = cc_ * 32 - 1 + r;                                    \
      const bool ok = pos >= 0 && pos < L;                                                                             \
      const int pc = ok ? pos : 0;                                                                                     \
      uint4 v = *(const uint4*)(hin + (size_t)(t0 + pc) * INW + 1792 + n * 64 + sg * 8);                               \
      rw1.x = ok ? v.x : 0u; rw1.y = ok ? v.y : 0u; rw1.z = ok ? v.z : 0u; rw1.w = ok ? v.w : 0u;                      \
    }                                                                                                                  \
    {                                                                                                                  \
      const int idx = gt + 256, r = idx >> 3, sg = idx & 7, pos = cc_ * 32 - 1 + r;                                    \
      const bool ok = idx < 280 && pos >= 0 && pos < L;                                                                \
      const int pc = ok ? pos : 0;                                                                                     \
      uint4 v = *(const uint4*)(hin + (size_t)(t0 + pc) * INW + 1792 + n * 64 + sg * 8);                               \
      rw2.x = ok ? v.x : 0u; rw2.y = ok ? v.y : 0u; rw2.z = ok ? v.z : 0u; rw2.w = ok ? v.w : 0u;                      \
    }                                                                                                                  \
  }
#define LRU_WRITE()                                                                         \
  {                                                                                         \
    *(uint4*)(bxs + (gt >> 3) * 64 + (gt & 7) * 8) = rw0;                                   \
    *(uint4*)(bxs + ((gt + 128) >> 3) * 64 + (gt & 7) * 8) = rw1;                           \
    if (gt + 256 < 280) *(uint4*)(bxs + ((gt + 256) >> 3) * 64 + (gt & 7) * 8) = rw2;       \
  }
  LRU_ISSUE(c_lo + (dir == 0 ? 0 : nch - 1))
  LRU_WRITE()
  for (int ci = 0; ci < nch; ++ci) {
    const int c = c_lo + (dir == 0 ? ci : nch - 1 - ci);
    const bool combine = !split && ci >= (nch >> 1);
    __syncthreads();
    if (ci + 1 < nch) LRU_ISSUE(dir == 0 ? c + 1 : c - 1)
    float4 py[4];
    uint2 pg[4];
    if (combine) {
#pragma unroll
      for (int q = 0; q < 4; ++q) {
        const int idx = gt + 128 * q, tok = idx >> 4, c4 = (idx & 15) * 4;
        const size_t t = (size_t)(t0 + c * 32 + tok);
        py[q] = *(const float4*)(yoth + t * 256 + n * 64 + c4);
        pg[q] = *(const uint2*)(hin + t * INW + 256 + n * 64 + c4);
      }
    }
    __builtin_amdgcn_sched_barrier(0);
    {
      const int tk0 = gw * 16;
      float xm1 = bf2f(bxs[(tk0 + 0) * 64 + lane]), x0 = bf2f(bxs[(tk0 + 1) * 64 + lane]), x1 = bf2f(bxs[(tk0 + 2) * 64 + lane]);
#pragma unroll
      for (int e = 0; e < 16; ++e) {
        const int tok = tk0 + e;
        const float x2 = bf2f(bxs[(tok + 3) * 64 + lane]);
        const float xc = cb + xm1 * cw0 + x0 * cw1 + x1 * cw2 + x2 * cw3;
        xcf[tok * 64 + lane] = xc;
        xcb[tok * LDT + lane] = f2bf(xc);
        xm1 = x0; x0 = x1; x1 = x2;
      }
    }
    __syncthreads();
    {
#pragma unroll
      for (int mt = 0; mt < 2; ++mt) {
        const bf16x8 a0 = *(const bf16x8*)(xcb + (mt * 16 + c16) * LDT + g * 8);
        const bf16x8 a1 = *(const bf16x8*)(xcb + (mt * 16 + c16) * LDT + 32 + g * 8);
#pragma unroll
        for (int kk = 0; kk < 2; ++kk) {
          const f32x4 z = {0.f, 0.f, 0.f, 0.f};
          f32x4 ar = mfma16(a1, wf[0][kk][1], mfma16(a0, wf[0][kk][0], z));
          f32x4 ai = mfma16(a1, wf[1][kk][1], mfma16(a0, wf[1][kk][0], z));
          const int ch = (2 * gw + kk) * 16 + c16;
#pragma unroll
          for (int i = 0; i < 4; ++i) {
            const int tok = mt * 16 + g * 4 + i;
            const float r = sigmoidf_(ar[i] + ba[kk]);
            const float ig = sigmoidf_(ai[i] + bx[kk]);
            const float a = __expf(r * sp[kk]);
            const float u = __builtin_amdgcn_sqrtf(fmaxf(1.f - a * a, 0.f)) * (ig * xcf[tok * 64 + ch]);
            af[tok * 64 + ch] = a;
            xcf[tok * 64 + ch] = u;
          }
        }
      }
    }
    __syncthreads();
    if (gw == 0) {
#pragma unroll 1
      for (int bt = 0; bt < 4; ++bt) {
        float av[8], uv[8];
#pragma unroll
        for (int j = 0; j < 8; ++j) {
          const int tok = dir == 0 ? bt * 8 + j : 31 - (bt * 8 + j);
          av[j] = af[tok * 64 + lane];
          uv[j] = xcf[tok * 64 + lane];
        }
#pragma unroll
        for (int j = 0; j < 8; ++j) {
          h = av[j] * h + uv[j];
          if (dep) {
            pp *= av[j];
            const int tok = dir == 0 ? bt * 8 + j : 31 - (bt * 8 + j);
            pbuf[(size_t)(t0 + c * 32 + tok) * 256 + n * 64 + lane] = pp;
          }
          av[j] = h;
        }
#pragma unroll
        for (int j = 0; j < 8; ++j) {
          const int tok = dir == 0 ? bt * 8 + j : 31 - (bt * 8 + j);
          af[tok * 64 + lane] = av[j];
        }
      }
    }
    __syncthreads();
    {
#pragma unroll
      for (int q = 0; q < 4; ++q) {
        const int idx = gt + 128 * q, tok = idx >> 4, c4 = (idx & 15) * 4;
        const size_t t = (size_t)(t0 + c * 32 + tok);
        const float4 hv = *(const float4*)(af + tok * 64 + c4);
        if (!combine) {
          *(float4*)(yown + t * 256 + n * 64 + c4) = hv;
        } else {
          uint2 ov;
          ov.x = pack2((hv.x + py[q].x) * siluf_(lo2f(pg[q].x)), (hv.y + py[q].y) * siluf_(hi2f(pg[q].x)));
          ov.y = pack2((hv.z + py[q].z) * siluf_(lo2f(pg[q].y)), (hv.w + py[q].w) * siluf_(hi2f(pg[q].y)));
          *(uint2*)(br + t * 1024 + 256 + n * 64 + c4) = ov;
        }
      }
      if (ci + 1 < nch) LRU_WRITE()
    }
  }
  if (gw == 0 && !sample) p.out[O_ST + ((size_t)(b * 2 + l) * 2 + dir) * 256 + n * 64 + lane] = h;
  if (split) {
    float* hend = (float*)(p.ws + WS_HEND) + (size_t)((b * 4 + n) * 2) * 64;
    if (gw == 0 && !dep) hend[dir * 64 + lane] = h;
    asm volatile("s_waitcnt vmcnt(0)" ::: "memory");
    __syncthreads();
    volatile int* sj = (volatile int*)(lds + LDS_BYTES - 16);
    if (threadIdx.x == 0) {
      __builtin_amdgcn_fence(__ATOMIC_RELEASE, "agent");
      asm volatile("s_waitcnt vmcnt(0)" ::: "memory");
      const unsigned old = xb_add((unsigned*)(p.ws + WS_BAR) + XB_JOBCTR(64 + l * 32 + b * 4 + n), 1u);
      if (old == 1u) {
        __builtin_amdgcn_fence(__ATOMIC_ACQUIRE, "agent");
        asm volatile("s_waitcnt vmcnt(0)" ::: "memory");
      }
      sj[2] = (int)old;
    }
    __syncthreads();
    if (sj[2] == 1) {
      const float* yf = (const float*)(p.ws + WS_YF);
      const float* yb = (const float*)(p.ws + WS_YB);
#pragma unroll 4
      for (int idx = tid; idx < 1024 * 16; idx += 256) {
        const int tok = idx >> 4, c4 = (idx & 15) * 4;
        const size_t t = (size_t)(t0 + tok);
        float4 f = *(const float4*)(yf + t * 256 + n * 64 + c4);
        float4 bk = *(const float4*)(yb + t * 256 + n * 64 + c4);
        const float4 pq = *(const float4*)(pbuf + t * 256 + n * 64 + c4);
        const uint2 gv = *(const uint2*)(hin + t * INW + 256 + n * 64 + c4);
        if (tok < 512) {
          const float4 hc = *(const float4*)(hend + 64 + c4);
          bk.x += pq.x * hc.x; bk.y += pq.y * hc.y; bk.z += pq.z * hc.z; bk.w += pq.w * hc.w;
        } else {
          const float4 hc = *(const float4*)(hend + c4);
          f.x += pq.x * hc.x; f.y += pq.y * hc.y; f.z += pq.z * hc.z; f.w += pq.w * hc.w;
        }
        uint2 ov;
        ov.x = pack2((f.x + bk.x) * siluf_(lo2f(gv.x)), (f.y + bk.y) * siluf_(hi2f(gv.x)));
        ov.y = pack2((f.z + bk.z) * siluf_(lo2f(gv.y)), (f.w + bk.w) * siluf_(hi2f(gv.y)));
        *(uint2*)(br + t * 1024 + 256 + n * 64 + c4) = ov;
      }
    }
  }
  __syncthreads();
}

__device__ void phase_mix(const Params& p, int l, unsigned char* lds) {
  const int NATT = 192;
  const int per_list = 16 + (l == 0 ? NATT + 122 : NATT);
  unsigned* ctrs = (unsigned*)(p.ws + WS_BAR) + XB_JOBCTR(128 + l * 8);
  volatile int* sjob = (volatile int*)(lds + LDS_BYTES - 16);
  for (bool first = true;; first = false) {
    const int res = next_tile(ctrs, per_list, first, sjob);
    if (res < 0) break;
    const int x = res / per_list, j = res % per_list;
    if (j < 8) { lru_job(p, l, 16 + x, j >> 1, j & 1, lds); continue; }
    if (j < 16) { const int jj = j - 8; lru_job(p, l, 2 * x + (jj >> 2), jj & 3, -1, lds); continue; }
    int a = j - 16;
    if (l == 0) {
      if (a < 244) {
        if (a & 1) {
          const int gid = x * 122 + (a >> 1);
          for (int q = 0; q < 4; ++q) weight_tile(p, 832 + gid * 4 + q, (float*)lds);
          continue;
        }
        a >>= 1;
      } else {
        a = 122 + (a - 244);
      }
    }
    if (a < 64) {
      attn_job<0, true, 1>(p, l, x, a >> 4, a & 15, lds);
    } else if (a < 96) {
      const int r = a - 64;
      attn_job<3, true, 2>(p, l, x, r >> 3, r & 7, lds);
    } else if (a < 128) {
      const int r = a - 96;
      attn_job<2, true, 2>(p, l, x, r >> 3, r & 7, lds);
    } else if (a < 160) {
      const int r = a - 128;
      attn_job<0, false, 1>(p, l, 2 * x + (r >> 4), (r >> 2) & 3, r & 3, lds);
    } else if (a < 176) {
      const int r = a - 160;
      attn_job<2, false, 2>(p, l, 2 * x + (r >> 3), (r >> 1) & 3, r & 1, lds);
    } else {
      const int r = a - 176;
      attn_job<3, false, 2>(p, l, 2 * x + (r >> 3), (r >> 1) & 3, r & 1, lds);
    }
  }
}

__device__ __forceinline__ unsigned long long rfl64(unsigned long long v) {
  const unsigned lo = __builtin_amdgcn_readfirstlane((unsigned)v), hi = __builtin_amdgcn_readfirstlane((unsigned)(v >> 32));
  return ((unsigned long long)hi << 32) | lo;
}
__device__ __forceinline__ Params get_params(const unsigned long long* sp) {
  Params q;
  q.x_prompt = (const float*)(const float __attribute__((address_space(1)))*)rfl64(sp[0]);
  q.x_sample = (const float*)(const float __attribute__((address_space(1)))*)rfl64(sp[1]);
  q.cdk = (const float*)(const float __attribute__((address_space(1)))*)rfl64(sp[2]);
  q.cdv = (const float*)(const float __attribute__((address_space(1)))*)rfl64(sp[3]);
  q.cnk = (const float*)(const float __attribute__((address_space(1)))*)rfl64(sp[4]);
  q.cnv = (const float*)(const float __attribute__((address_space(1)))*)rfl64(sp[5]);
  q.csk = (const float*)(const float __attribute__((address_space(1)))*)rfl64(sp[6]);
  q.csv = (const float*)(const float __attribute__((address_space(1)))*)rfl64(sp[7]);
  q.state = (const float*)(const float __attribute__((address_space(1)))*)rfl64(sp[8]);
  q.c = (const float*)(const float __attribute__((address_space(1)))*)rfl64(sp[9]);
  q.c_ctx = (const float*)(const float __attribute__((address_space(1)))*)rfl64(sp[10]);
  q.norm_g = (const float*)(const float __attribute__((address_space(1)))*)rfl64(sp[11]);
  q.w_ada = (const float*)(const float __attribute__((address_space(1)))*)rfl64(sp[12]);
  q.b_ada = (const float*)(const float __attribute__((address_space(1)))*)rfl64(sp[13]);
  q.w_in = (const float*)(const float __attribute__((address_space(1)))*)rfl64(sp[14]);
  q.dlam = (const float*)(const float __attribute__((address_space(1)))*)rfl64(sp[15]);
  q.dg = (const float*)(const float __attribute__((address_space(1)))*)rfl64(sp[16]);
  q.conv_w = (const float*)(const float __attribute__((address_space(1)))*)rfl64(sp[17]);
  q.conv_b = (const float*)(const float __attribute__((address_space(1)))*)rfl64(sp[18]);
  q.lru_wa = (const float*)(const float __attribute__((address_space(1)))*)rfl64(sp[19]);
  q.lru_ba = (const float*)(const float __attribute__((address_space(1)))*)rfl64(sp[20]);
  q.lru_wx = (const float*)(const float __attribute__((address_space(1)))*)rfl64(sp[21]);
  q.lru_bx = (const float*)(const float __attribute__((address_space(1)))*)rfl64(sp[22]);
  q.lru_lam = (const float*)(const float __attribute__((address_space(1)))*)rfl64(sp[23]);
  q.rpb = (const float*)(const float __attribute__((address_space(1)))*)rfl64(sp[24]);
  q.sink = (const float*)(const float __attribute__((address_space(1)))*)rfl64(sp[25]);
  q.w_mg = (const float*)(const float __attribute__((address_space(1)))*)rfl64(sp[26]);
  q.b_mg = (const float*)(const float __attribute__((address_space(1)))*)rfl64(sp[27]);
  q.w_bo = (const float*)(const float __attribute__((address_space(1)))*)rfl64(sp[28]);
  q.w_o = (const float*)(const float __attribute__((address_space(1)))*)rfl64(sp[29]);
  q.norm_f = (const float*)(const float __attribute__((address_space(1)))*)rfl64(sp[30]);
  q.out = (float*)(float __attribute__((address_space(1)))*)rfl64(sp[31]);
  q.ws = (unsigned char*)(unsigned char __attribute__((address_space(1)))*)rfl64(sp[32]);
  q.ph_lo = 0;
  q.ph_hi = 12;
  return q;
}

__global__ void __launch_bounds__(256, 2) fwd_megakernel(Params p) {
  __shared__ __attribute__((aligned(16))) unsigned char lds[LDS_BYTES];
  __shared__ uint4 xb_words;
  __shared__ unsigned long long sparams[34];
  cg::grid_group grid = cg::this_grid();
  if (threadIdx.x == 0) {
    xb_words = make_uint4(0u, 0u, 0u, 0u);
    sparams[0] = (unsigned long long)p.x_prompt;
    sparams[1] = (unsigned long long)p.x_sample;
    sparams[2] = (unsigned long long)p.cdk;
    sparams[3] = (unsigned long long)p.cdv;
    sparams[4] = (unsigned long long)p.cnk;
    sparams[5] = (unsigned long long)p.cnv;
    sparams[6] = (unsigned long long)p.csk;
    sparams[7] = (unsigned long long)p.csv;
    sparams[8] = (unsigned long long)p.state;
    sparams[9] = (unsigned long long)p.c;
    sparams[10] = (unsigned long long)p.c_ctx;
    sparams[11] = (unsigned long long)p.norm_g;
    sparams[12] = (unsigned long long)p.w_ada;
    sparams[13] = (unsigned long long)p.b_ada;
    sparams[14] = (unsigned long long)p.w_in;
    sparams[15] = (unsigned long long)p.dlam;
    sparams[16] = (unsigned long long)p.dg;
    sparams[17] = (unsigned long long)p.conv_w;
    sparams[18] = (unsigned long long)p.conv_b;
    sparams[19] = (unsigned long long)p.lru_wa;
    sparams[20] = (unsigned long long)p.lru_ba;
    sparams[21] = (unsigned long long)p.lru_wx;
    sparams[22] = (unsigned long long)p.lru_bx;
    sparams[23] = (unsigned long long)p.lru_lam;
    sparams[24] = (unsigned long long)p.rpb;
    sparams[25] = (unsigned long long)p.sink;
    sparams[26] = (unsigned long long)p.w_mg;
    sparams[27] = (unsigned long long)p.b_mg;
    sparams[28] = (unsigned long long)p.w_bo;
    sparams[29] = (unsigned long long)p.w_o;
    sparams[30] = (unsigned long long)p.norm_f;
    sparams[31] = (unsigned long long)p.out;
    sparams[32] = (unsigned long long)p.ws;
  }
  __syncthreads();
  (void)xcd_barrier_post((unsigned*)(p.ws + WS_BAR), (volatile LAS unsigned*)&xb_words);
  if (p.ph_hi < 0) grid.sync();
#define RUN(PH, CALL)                                  \
  {                                                    \
    const Params q = get_params(sparams);              \
    CALL;                                              \
    if ((PH) + 1 < 12) {                               \
      XcdBarrier xb2;                                  \
      xb2.bar = (unsigned*)((unsigned char*)(unsigned char __attribute__((address_space(1)))*)rfl64(sparams[32]) + WS_BAR); \
      xb2.x = xb_xcc_id();                             \
      xb2.st = (volatile LAS unsigned*)&xb_words;      \
      xcd_barrier(xb2);                                \
    }                                                  \
  }
  RUN(0, phase_prep(q, lds))
#pragma unroll 1
  for (int l = 0; l < 2; ++l) {
    RUN(1 + 5 * l, phase_norm(q, l))
    RUN(2 + 5 * l, phase_gemm1(q, l, lds))
    RUN(3 + 5 * l, phase_mix(q, l, lds))
    RUN(4 + 5 * l, phase_merge(q, l, lds))
    RUN(5 + 5 * l, phase_out(q, l, lds))
  }
  RUN(11, phase_final(q))
}

extern "C" void kernel_launch(void* const* d_in, const int* in_sizes, int n_in, void* d_out, int out_size, void* d_ws,
                              size_t ws_size, hipStream_t stream) {
  static int grid_blocks = 0;
  if (!grid_blocks) {
    int dev = 0, cus = 0, per_cu = 0;
    (void)hipGetDevice(&dev);
    (void)hipDeviceGetAttribute(&cus, hipDeviceAttributeMultiprocessorCount, dev);
    (void)hipOccupancyMaxActiveBlocksPerMultiprocessor(&per_cu, fwd_megakernel, 256, 0);
    if (per_cu < 1) per_cu = 1;
    if (per_cu > 2) per_cu = 2;
    grid_blocks = cus * per_cu;
    if (ws_size < WS_TOTAL) fprintf(stderr, "kernel_launch: workspace too small: %zu < %zu\n", ws_size, (size_t)WS_TOTAL);
  }
  Params p{};
  const float** pp = (const float**)&p;
  for (int i = 0; i < 31; ++i) pp[i] = (const float*)d_in[i];
  p.out = (float*)d_out;
  p.ws = (unsigned char*)d_ws;
  p.ph_lo = 0;
  p.ph_hi = 12;
  (void)hipMemsetAsync((unsigned char*)d_ws + WS_BAR, 0, BAR_TOTAL_WORDS * 4, stream);
  void* args[] = {&p};
  hipError_t e = hipLaunchCooperativeKernel((void*)fwd_megakernel, dim3(grid_blocks), dim3(256), args, 0, stream);
  if (e != hipSuccess) fprintf(stderr, "cooperative launch failed: %s (grid %d)\n", hipGetErrorString(e), grid_blocks);
}
```

```cpp
#include <hip/hip_runtime.h>
#include <hip/hip_cooperative_groups.h>
#include <cstdio>
#include <cstdint>
namespace cg = cooperative_groups;

typedef __attribute__((ext_vector_type(8))) short bf16x8;
typedef __attribute__((ext_vector_type(4))) float f32x4;
typedef unsigned short bf16_t;

#define T_TOK 12288
#define T_PR 4096
#define INW 3328

struct Params {
  const float *x_prompt, *x_sample, *cdk, *cdv, *cnk, *cnv, *csk, *csv, *state, *c, *c_ctx, *norm_g, *w_ada, *b_ada,
      *w_in, *dlam, *dg, *conv_w, *conv_b, *lru_wa, *lru_ba, *lru_wx, *lru_bx, *lru_lam, *rpb, *sink, *w_mg, *b_mg,
      *w_bo, *w_o, *norm_f;
  float* out;
  unsigned char* ws;
  int ph_lo, ph_hi;
};

constexpr size_t WS_WIN = 0;
constexpr size_t WS_WMG = WS_WIN + (size_t)2 * 3328 * 1024 * 2;
constexpr size_t WS_WBO = WS_WMG + (size_t)2 * 4096 * 1024 * 2;
constexpr size_t WS_WO = WS_WBO + (size_t)2 * 4 * 1024 * 256 * 2;
constexpr size_t WS_WLRU = WS_WO + (size_t)2 * 1024 * 1024 * 2;
constexpr size_t WS_MOD = WS_WLRU + (size_t)32 * 4096 * 2;
constexpr size_t WS_CVA = WS_MOD + (size_t)2 * 9 * 3072 * 4;
constexpr size_t WS_CVC = WS_CVA + (size_t)64 * 64 * 512 * 2;
constexpr size_t WS_CVD = WS_CVC + (size_t)64 * 64 * 512 * 2;
constexpr size_t WS_TABA = WS_CVD + (size_t)32 * 64 * 512 * 2;
constexpr size_t WS_TABD = WS_TABA + 64 * 8 * 8;
constexpr size_t WS_H = WS_TABD + 64 * 16 * 8;
constexpr size_t WS_HIN = WS_H + (size_t)T_TOK * 1024 * 2;
constexpr size_t WS_AVT = WS_HIN + (size_t)T_TOK * INW * 2;
constexpr size_t WS_CVT = WS_AVT + (size_t)3145728 * 2;
constexpr size_t WS_DVT = WS_CVT + (size_t)3145728 * 2;
constexpr size_t WS_BR = WS_DVT + (size_t)1572864 * 2;
constexpr size_t WS_YF = WS_BR + (size_t)T_TOK * 1024 * 2;
constexpr size_t WS_YB = WS_YF + (size_t)T_TOK * 256 * 4;
constexpr size_t WS_PB = WS_YB + (size_t)T_TOK * 256 * 4;
constexpr size_t WS_HEND = WS_PB + (size_t)T_TOK * 256 * 4;
constexpr size_t WS_END = WS_HEND + 16384;
constexpr size_t WS_MB = WS_HIN;
constexpr size_t WS_BAR = WS_END;
constexpr size_t WS_TOTAL = WS_BAR + 32768;
static_assert(WS_TOTAL <= (size_t)256 * 1024 * 1024, "workspace map exceeds the guaranteed 256 MiB");

constexpr size_t O_Y = 0;
constexpr size_t O_DK = 12582912;
constexpr size_t O_DV = 14680064;
constexpr size_t O_NK = 16777216;
constexpr size_t O_NV = 18874368;
constexpr size_t O_SK = 20971520;
constexpr size_t O_SV = 22020096;
constexpr size_t O_ST = 23068672;

#define LDS_BYTES 53248

__device__ __forceinline__ int tid_opaque() {
  int t = threadIdx.x;
  asm volatile("" : "+v"(t));
  return t;
}
#define TIDX tid_opaque()
__device__ __forceinline__ unsigned pack2(float a, float b) {
  typedef __attribute__((ext_vector_type(2))) __bf16 bf2_t;
  typedef __attribute__((ext_vector_type(2))) float f2_t;
  f2_t v = {a, b};
  bf2_t r = __builtin_convertvector(v, bf2_t);
  return __builtin_bit_cast(unsigned, r);
}
__device__ __forceinline__ bf16_t f2bf(float f) { return (bf16_t)(pack2(f, 0.f) & 0xffffu); }
__device__ __forceinline__ float bf2f(bf16_t h) { return __uint_as_float(((unsigned)h) << 16); }
__device__ __forceinline__ float lo2f(unsigned u) { return __uint_as_float(u << 16); }
__device__ __forceinline__ float hi2f(unsigned u) { return __uint_as_float(u & 0xffff0000u); }
__device__ __forceinline__ float sigmoidf_(float x) { return __builtin_amdgcn_rcpf(1.f + __builtin_amdgcn_exp2f(-1.4426950408889634f * x)); }
__device__ __forceinline__ float siluf_(float x) { return x * __builtin_amdgcn_rcpf(1.f + __builtin_amdgcn_exp2f(-1.4426950408889634f * x)); }
__device__ __forceinline__ float wave_sum(float v) {
#pragma unroll
  for (int o = 32; o >= 1; o >>= 1) v += __shfl_xor(v, o);
  return v;
}
__device__ __forceinline__ float rowmax4(float x) {
  unsigned u = __float_as_uint(x);
  auto r32 = __builtin_amdgcn_permlane32_swap(u, u, false, false);
  const float m = fmaxf(__uint_as_float(r32[0]), __uint_as_float(r32[1]));
  unsigned v = __float_as_uint(m);
  auto r16 = __builtin_amdgcn_permlane16_swap(v, v, false, false);
  return fmaxf(__uint_as_float(r16[0]), __uint_as_float(r16[1]));
}
__device__ __forceinline__ f32x4 mfma16(bf16x8 a, bf16x8 b, f32x4 c) {
  return __builtin_amdgcn_mfma_f32_16x16x32_bf16(a, b, c, 0, 0, 0);
}
__device__ __forceinline__ const float* xrow(const Params& p, int l, int t) {
  if (l == 0) return t < T_PR ? p.x_prompt + (size_t)t * 1024 : p.x_sample + (size_t)(t - T_PR) * 1024;
  return p.out + O_Y + (size_t)t * 1024;
}


#define XB_TMO      128
#define XB_XCNT(j)  (256  + 64 * (j))
#define XB_XSUB(j)  (1280 + 64 * (j))
#define XB_XGEN(j)  (2304 + 64 * (j))
#define XB_TOP      3328
#define XB_TOPGEN   3392
#define XCD_BAR_WORDS 3456
#define XB_JOBCTR(i) (3456 + 16 * (i))
#define BAR_TOTAL_WORDS (3456 + 16 * 160)
#define XB_SPIN_CAP (1u << 22)
#define LAS __attribute__((address_space(3)))
__device__ __forceinline__ unsigned xb_ld(unsigned* p) { return __hip_atomic_load(p, __ATOMIC_RELAXED, __HIP_MEMORY_SCOPE_AGENT); }
__device__ __forceinline__ unsigned xb_add(unsigned* p, unsigned v) { return __hip_atomic_fetch_add(p, v, __ATOMIC_RELAXED, __HIP_MEMORY_SCOPE_AGENT); }
__device__ __forceinline__ unsigned xb_xcc_id() { return (unsigned)__builtin_amdgcn_s_getreg((3 << 11) | 20) & 0xFu; }
#define XB_SPIN(cond, bar) do { unsigned _sp = 0; while (cond) { __builtin_amdgcn_s_sleep(1); \
    if ((++_sp & 255u) == 0u) { if (xb_ld(&(bar)[XB_TMO])) break; if (_sp > XB_SPIN_CAP) { atomicAdd(&(bar)[XB_TMO], 1u); break; } } } } while (0)
struct XcdBarrier { unsigned* bar; unsigned x; volatile LAS unsigned* st; };
__device__ __forceinline__ XcdBarrier xcd_barrier_post(unsigned* bar, volatile LAS unsigned* st) {
  XcdBarrier b; b.bar = bar; b.x = xb_xcc_id(); b.st = st;
  if (threadIdx.x == 0) (void)xb_add(&bar[XB_XCNT(b.x)], 1u);
  return b;
}
__device__ __forceinline__ void xcd_barrier_complete(unsigned* bar, unsigned x, unsigned& nloc, unsigned& nx) {
  const unsigned G = gridDim.x * gridDim.y * gridDim.z;
  unsigned sum, cnt, mine, sp = 0u;
  for (;;) {
    sum = 0u; cnt = 0u; mine = 0u;
#pragma unroll
    for (unsigned j = 0; j < 16; ++j) { const unsigned c = xb_ld(&bar[XB_XCNT(j)]); sum += c; cnt += (c > 0u) ? 1u : 0u; mine = (j == x) ? c : mine; }
    if (sum == G) break;
    __builtin_amdgcn_s_sleep(1);
    if ((++sp & 255u) == 0u) { if (xb_ld(&bar[XB_TMO])) break; if (sp > XB_SPIN_CAP) { atomicAdd(&bar[XB_TMO], 1u); break; } }
  }
  nloc = mine > 0u ? mine : 1u; nx = cnt > 0u ? cnt : 1u;
}
__device__ __forceinline__ void xcd_barrier(const XcdBarrier& b) {
  asm volatile("s_waitcnt vmcnt(0)" ::: "memory");
  __syncthreads();
  if (threadIdx.x == 0) {
    unsigned* bar = b.bar;
    __builtin_amdgcn_s_waitcnt(0);
    unsigned nloc = b.st[0], nx = b.st[1];
    if (nloc == 0u) { xcd_barrier_complete(bar, b.x, nloc, nx); b.st[0] = nloc; b.st[1] = nx; }
    const unsigned old = xb_add(&bar[XB_XSUB(b.x)], 1u);
    const unsigned gen = old / nloc;
    if (old + 1u == (gen + 1u) * nloc) {
      __builtin_amdgcn_fence(__ATOMIC_RELEASE, "agent");
      asm volatile("s_waitcnt vmcnt(0)" ::: "memory");
      const unsigned og = xb_add(&bar[XB_TOP], 1u);
      const unsigned tg = og / nx;
      if (og + 1u == (tg + 1u) * nx) xb_add(&bar[XB_TOPGEN], 1u);
      else XB_SPIN(xb_ld(&bar[XB_TOPGEN]) == tg, bar);
      __builtin_amdgcn_fence(__ATOMIC_ACQUIRE, "agent");
      xb_add(&bar[XB_XGEN(b.x)], 1u);
      asm volatile("s_waitcnt vmcnt(0)" ::: "memory");
    } else {
      XB_SPIN(xb_ld(&bar[XB_XGEN(b.x)]) == gen, bar);
      __builtin_amdgcn_fence(__ATOMIC_ACQUIRE, "agent");
      asm volatile("s_waitcnt vmcnt(0)" ::: "memory");
    }
  }
  __syncthreads();
}

__device__ void transpose_tile(const float* __restrict__ src, int sld, bf16_t* __restrict__ dst, int dld, float* tile) {
  const int tid = TIDX;
  {
    const int r0 = tid >> 4, c4 = (tid & 15) * 4;
#pragma unroll
    for (int i = 0; i < 4; ++i) {
      const int r = r0 + 16 * i;
      const float4 v = *(const float4*)(src + (size_t)r * sld + c4);
      tile[r * 65 + c4 + 0] = v.x;
      tile[r * 65 + c4 + 1] = v.y;
      tile[r * 65 + c4 + 2] = v.z;
      tile[r * 65 + c4 + 3] = v.w;
    }
  }
  __syncthreads();
  {
    const int r8 = (tid & 7) * 8, c0 = tid >> 3;
#pragma unroll
    for (int i = 0; i < 2; ++i) {
      const int c = c0 + 32 * i;
      uint4 o;
      o.x = pack2(tile[(r8 + 0) * 65 + c], tile[(r8 + 1) * 65 + c]);
      o.y = pack2(tile[(r8 + 2) * 65 + c], tile[(r8 + 3) * 65 + c]);
      o.z = pack2(tile[(r8 + 4) * 65 + c], tile[(r8 + 5) * 65 + c]);
      o.w = pack2(tile[(r8 + 6) * 65 + c], tile[(r8 + 7) * 65 + c]);
      *(uint4*)(dst + (size_t)c * dld + r8) = o;
    }
  }
  __syncthreads();
}

__device__ void weight_tile(const Params& p, int job, float* tile) {
  const int NT_LAYER = 832 + 1024 + 256 + 256;
  {
      int l = job / NT_LAYER, j = job % NT_LAYER;
      if (j < 832) {
        int kt = j / 52, nt = j % 52;
        transpose_tile(p.w_in + (size_t)l * 1024 * 3328 + (size_t)kt * 64 * 3328 + nt * 64, 3328,
                       (bf16_t*)(p.ws + WS_WIN) + (size_t)l * 3328 * 1024 + (size_t)nt * 64 * 1024 + kt * 64, 1024, tile);
      } else if (j < 832 + 1024) {
        j -= 832;
        int kt = j / 64, nt = j % 64;
        transpose_tile(p.w_mg + (size_t)l * 1024 * 4096 + (size_t)kt * 64 * 4096 + nt * 64, 4096,
                       (bf16_t*)(p.ws + WS_WMG) + (size_t)l * 4096 * 1024 + (size_t)nt * 64 * 1024 + kt * 64, 1024, tile);
      } else if (j < 832 + 1024 + 256) {
        j -= 832 + 1024;
        int n = j / 64, r = j % 64, wt = r / 16, mt = r % 16;
        transpose_tile(p.w_bo + ((size_t)(l * 4 + n) * 256 + wt * 64) * 1024 + mt * 64, 1024,
                       (bf16_t*)(p.ws + WS_WBO) + ((size_t)(l * 4 + n) * 1024 + mt * 64) * 256 + wt * 64, 256, tile);
      } else {
        j -= 832 + 1024 + 256;
        int kt = j / 16, nt = j % 16;
        transpose_tile(p.w_o + (size_t)l * 1024 * 1024 + (size_t)kt * 64 * 1024 + nt * 64, 1024,
                       (bf16_t*)(p.ws + WS_WO) + (size_t)l * 1024 * 1024 + (size_t)nt * 64 * 1024 + kt * 64, 1024, tile);
      }
  }
}

__device__ void phase_prep(const Params& p, unsigned char* lds) {
  float* tile = (float*)lds;
  const int NT_LAYER = 832 + 1024 + 256 + 256;
  const int NT_W = 2 * NT_LAYER;
  const int NT_LRU = 32;
  const int NT_CV = 512 + 512 + 256;
  const int NT_ALL = NT_W + NT_LRU + NT_CV;
  const int N_MOD = 384;
  const int NJ = NT_ALL + N_MOD + 1;
  bf16_t* wsb = (bf16_t*)p.ws;
  for (int job = blockIdx.x; job < NJ; job += gridDim.x) {
    if (job < NT_W) {
      if (job < 832) weight_tile(p, job, tile);
    } else if (job < NT_W + NT_LRU) {
      int j = job - NT_W;
      int gate = j & 1, rest = j >> 1;
      transpose_tile((gate ? p.lru_wx : p.lru_wa) + (size_t)rest * 4096, 64, (bf16_t*)(p.ws + WS_WLRU) + (size_t)j * 4096, 64, tile);
    } else if (job < NT_ALL) {
      int j = job - NT_W - NT_LRU;
      if (j < 512) {
        int mat = j >> 3, kt = j & 7;
        transpose_tile(p.cdv + (size_t)mat * 512 * 64 + (size_t)kt * 64 * 64, 64, (bf16_t*)(p.ws + WS_CVA) + (size_t)mat * 64 * 512 + kt * 64, 512, tile);
      } else if (j < 1024) {
        j -= 512;
        int mat = j >> 3, kt = j & 7;
        transpose_tile(p.cnv + (size_t)mat * 512 * 64 + (size_t)kt * 64 * 64, 64, (bf16_t*)(p.ws + WS_CVC) + (size_t)mat * 64 * 512 + kt * 64, 512, tile);
      } else {
        j -= 1024;
        int mat = j >> 3, kt = j & 7;
        transpose_tile(p.csv + (size_t)mat * 512 * 64 + (size_t)kt * 64 * 64, 64, (bf16_t*)(p.ws + WS_CVD) + (size_t)mat * 64 * 512 + kt * 64, 512, tile);
      }
    } else if (job < NT_ALL + N_MOD) {
      int j = job - NT_ALL;
      int l = j / 192, j0 = (j % 192) * 16;
      float* sc = (float*)lds;
      const int tid = TIDX;
      for (int e = tid; e < 9 * 1024; e += 256) {
        int v = e >> 10, k = e & 1023;
        float cvv = v == 0 ? p.c_ctx[k] : p.c[(v - 1) * 1024 + k];
        sc[e] = siluf_(cvv);
      }
      __syncthreads();
      const int jj = tid & 15, ks = tid >> 4;
      float acc[9];
#pragma unroll
      for (int v = 0; v < 9; ++v) acc[v] = 0.f;
      const float* wp = p.w_ada + (size_t)l * 1024 * 3072 + j0 + jj;
#pragma unroll 8
      for (int kk = 0; kk < 64; ++kk) {
        int k = ks * 64 + kk;
        float w = wp[(size_t)k * 3072];
#pragma unroll
        for (int v = 0; v < 9; ++v) acc[v] += sc[v * 1024 + k] * w;
      }
      __syncthreads();
      float* red = (float*)lds;
#pragma unroll
      for (int v = 0; v < 9; ++v) red[(ks * 9 + v) * 16 + jj] = acc[v];
      __syncthreads();
      if (tid < 144) {
        int v = tid >> 4, j2 = tid & 15;
        float s = p.b_ada[(size_t)l * 3072 + j0 + j2];
        for (int q = 0; q < 16; ++q) s += red[(q * 9 + v) * 16 + j2];
        ((float*)(p.ws + WS_MOD))[((size_t)l * 9 + v) * 3072 + j0 + j2] = s;
      }
      __syncthreads();
    } else {
      float2* ta = (float2*)(p.ws + WS_TABA);
      float2* td = (float2*)(p.ws + WS_TABD);
      for (int e = TIDX; e < 64 * 8 + 64 * 16; e += 256) {
        if (e < 512) {
          int pos = e >> 3, i = e & 7;
          float inv = powf(10000.f, -(float)i / 8.f);
          float ang = (float)pos * inv;
          ta[e] = make_float2(cosf(ang), sinf(ang));
        } else {
          int e2 = e - 512;
          int pos = e2 >> 4, i = e2 & 15;
          float inv = powf(10000.f, -(float)i / 16.f);
          float ang = (float)pos * inv;
          td[e2] = make_float2(cosf(ang), sinf(ang));
        }
      }
    }
  }
  (void)wsb;
}

__device__ void phase_norm(const Params& p, int l) {
  const int wave = TIDX >> 6, lane = TIDX & 63;
  const float* modl = (const float*)(p.ws + WS_MOD) + (size_t)l * 9 * 3072;
  bf16_t* hb = (bf16_t*)(p.ws + WS_H);
  const float* gp = p.norm_g + l * 1024;
  for (int t = blockIdx.x * 4 + wave; t < T_TOK; t += gridDim.x * 4) {
    const float* xr = xrow(p, l, t);
    const int v = t < T_PR ? 0 : 1 + ((t - T_PR) >> 10);
    const float* shift = modl + v * 3072;
    const float* scale = shift + 1024;
    float4 xv[4];
    float ss = 0.f;
#pragma unroll
    for (int j = 0; j < 4; ++j) {
      xv[j] = *(const float4*)(xr + j * 256 + lane * 4);
      ss += xv[j].x * xv[j].x + xv[j].y * xv[j].y + xv[j].z * xv[j].z + xv[j].w * xv[j].w;
    }
    ss = wave_sum(ss);
    const float rinv = rsqrtf(ss * (1.f / 1024.f) + 1e-6f);
#pragma unroll
    for (int j = 0; j < 4; ++j) {
      const int c = j * 256 + lane * 4;
      float4 gg = *(const float4*)(gp + c), sc = *(const float4*)(scale + c), sh = *(const float4*)(shift + c);
      float h0 = xv[j].x * rinv * gg.x * (1.f + sc.x) + sh.x;
      float h1 = xv[j].y * rinv * gg.y * (1.f + sc.y) + sh.y;
      float h2 = xv[j].z * rinv * gg.z * (1.f + sc.z) + sh.z;
      float h3 = xv[j].w * rinv * gg.w * (1.f + sc.w) + sh.w;
      uint2 o;
      o.x = pack2(h0, h1);
      o.y = pack2(h2, h3);
      *(uint2*)(hb + (size_t)t * 1024 + c) = o;
    }
  }
}

__device__ void phase_final(const Params& p) {
  const int wave = TIDX >> 6, lane = TIDX & 63;
  for (int t = blockIdx.x * 4 + wave; t < T_TOK; t += gridDim.x * 4) {
    float* xr = p.out + O_Y + (size_t)t * 1024;
    float4 xv[4];
    float ss = 0.f;
#pragma unroll
    for (int j = 0; j < 4; ++j) {
      xv[j] = *(const float4*)(xr + j * 256 + lane * 4);
      ss += xv[j].x * xv[j].x + xv[j].y * xv[j].y + xv[j].z * xv[j].z + xv[j].w * xv[j].w;
    }
    ss = wave_sum(ss);
    const float rinv = rsqrtf(ss * (1.f / 1024.f) + 1e-6f);
#pragma unroll
    for (int j = 0; j < 4; ++j) {
      const int c = j * 256 + lane * 4;
      float4 gg = *(const float4*)(p.norm_f + c);
      float4 o;
      o.x = xv[j].x * rinv * gg.x;
      o.y = xv[j].y * rinv * gg.y;
      o.z = xv[j].z * rinv * gg.z;
      o.w = xv[j].w * rinv * gg.w;
      *(float4*)(xr + c) = o;
    }
  }
}

__device__ __forceinline__ int next_tile(unsigned* ctrs, int per_list, bool first, volatile int* sjob) {
  __syncthreads();
  if (threadIdx.x == 0) {
    int res = -1;
    int cur = first ? 0 : sjob[1];
    const unsigned x = xb_xcc_id();
    while (cur < 8) {
      const int lst = (int)((x + (unsigned)cur) & 7u);
      const int v = (int)xb_add(ctrs + lst * 16, 1u);
      if (v < per_list) { res = lst * per_list + v; break; }
      ++cur;
    }
    sjob[1] = cur;
    sjob[0] = res;
  }
  __syncthreads();
  return sjob[0];
}

#define LDT 80
#define LDV 72
template <int NI, bool FDB = true, bool SWAP = false>
__device__ __forceinline__ void gemm_accum(f32x4 (&acc)[4][NI], const bf16_t* __restrict__ A, int lda,
                                           const bf16_t* __restrict__ Bt, int ldb, int K, bf16_t* As, bf16_t* Bs, int bqrows = 32) {
  const int tid = TIDX, lane = tid & 63, wave = tid >> 6, wm = wave >> 1, wn = wave & 1, g = lane >> 4, c16 = lane & 15;
  const int lr = tid >> 3, lc = (tid & 7) * 8;
  const bf16_t* ap = A + (size_t)lr * lda + lc;
  const bf16_t* bp = Bt + (size_t)lr * ldb + lc;
  const size_t a32 = (size_t)32 * lda, b32 = (size_t)bqrows * ldb;
  uint4 ra0 = *(const uint4*)(ap), ra1 = *(const uint4*)(ap + a32), ra2 = *(const uint4*)(ap + 2 * a32), ra3 = *(const uint4*)(ap + 3 * a32);
  uint4 rb0 = *(const uint4*)(bp), rb1 = *(const uint4*)(bp + b32), rb2, rb3;
  if (NI == 4) { rb2 = *(const uint4*)(bp + 2 * b32); rb3 = *(const uint4*)(bp + 3 * b32); }
  for (int k0 = 0; k0 < K; k0 += 64) {
    *(uint4*)(As + (lr + 0) * LDT + lc) = ra0;
    *(uint4*)(As + (lr + 32) * LDT + lc) = ra1;
    *(uint4*)(As + (lr + 64) * LDT + lc) = ra2;
    *(uint4*)(As + (lr + 96) * LDT + lc) = ra3;
    *(uint4*)(Bs + (lr + 0) * LDT + lc) = rb0;
    *(uint4*)(Bs + (lr + 32) * LDT + lc) = rb1;
    if (NI == 4) {
      *(uint4*)(Bs + (lr + 64) * LDT + lc) = rb2;
      *(uint4*)(Bs + (lr + 96) * LDT + lc) = rb3;
    }
    __syncthreads();
    {
      const int kn = (k0 + 64 < K) ? k0 + 64 : k0;
      ra0 = *(const uint4*)(ap + kn);
      ra1 = *(const uint4*)(ap + a32 + kn);
      ra2 = *(const uint4*)(ap + 2 * a32 + kn);
      ra3 = *(const uint4*)(ap + 3 * a32 + kn);
      rb0 = *(const uint4*)(bp + kn);
      rb1 = *(const uint4*)(bp + b32 + kn);
      if (NI == 4) {
        rb2 = *(const uint4*)(bp + 2 * b32 + kn);
        rb3 = *(const uint4*)(bp + 3 * b32 + kn);
      }
    }
    __builtin_amdgcn_sched_barrier(0);
    if (FDB) {
      bf16x8 af0[4], bf0[NI], af1[4], bf1[NI];
      const bf16_t* arow = As + (wm * 64 + c16) * LDT + g * 8;
      const bf16_t* brow = Bs + (wn * 16 * NI + c16) * LDT + g * 8;
#pragma unroll
      for (int i = 0; i < 4; ++i) af0[i] = *(const bf16x8*)(arow + i * 16 * LDT);
#pragma unroll
      for (int j = 0; j < NI; ++j) bf0[j] = *(const bf16x8*)(brow + j * 16 * LDT);
#pragma unroll
      for (int i = 0; i < 4; ++i) af1[i] = *(const bf16x8*)(arow + i * 16 * LDT + 32);
#pragma unroll
      for (int j = 0; j < NI; ++j) bf1[j] = *(const bf16x8*)(brow + j * 16 * LDT + 32);
      __builtin_amdgcn_sched_barrier(0);
#pragma unroll
      for (int i = 0; i < 4; ++i)
#pragma unroll
        for (int j = 0; j < NI; ++j) acc[i][j] = SWAP ? mfma16(bf0[j], af0[i], acc[i][j]) : mfma16(af0[i], bf0[j], acc[i][j]);
#pragma unroll
      for (int i = 0; i < 4; ++i)
#pragma unroll
        for (int j = 0; j < NI; ++j) acc[i][j] = SWAP ? mfma16(bf1[j], af1[i], acc[i][j]) : mfma16(af1[i], bf1[j], acc[i][j]);
    } else {
#pragma unroll
      for (int ks = 0; ks < 2; ++ks) {
        bf16x8 af[4], bfr[NI];
#pragma unroll
        for (int i = 0; i < 4; ++i) af[i] = *(const bf16x8*)(As + (wm * 64 + i * 16 + c16) * LDT + ks * 32 + g * 8);
#pragma unroll
        for (int j = 0; j < NI; ++j) bfr[j] = *(const bf16x8*)(Bs + (wn * 16 * NI + j * 16 + c16) * LDT + ks * 32 + g * 8);
#pragma unroll
        for (int i = 0; i < 4; ++i)
#pragma unroll
          for (int j = 0; j < NI; ++j) acc[i][j] = SWAP ? mfma16(bfr[j], af[i], acc[i][j]) : mfma16(af[i], bfr[j], acc[i][j]);
      }
    }
    __syncthreads();
  }
}

__device__ void phase_gemm1(const Params& p, int l, unsigned char* lds) {
  bf16_t* As = (bf16_t*)lds;
  bf16_t* Bs = As + 128 * LDT;
  const bf16_t* hb = (const bf16_t*)(p.ws + WS_H);
  const bf16_t* wt = (const bf16_t*)(p.ws + WS_WIN) + (size_t)l * 3328 * 1024;
  bf16_t* hin = (bf16_t*)(p.ws + WS_HIN);
  const float2* tabA = (const float2*)(p.ws + WS_TABA);
  const float2* tabD = (const float2*)(p.ws + WS_TABD);
  const int lane = TIDX & 63, wave = TIDX >> 6, wm = wave >> 1, wn = wave & 1, g = lane >> 4, c16 = lane & 15;
  unsigned* ctrs = (unsigned*)(p.ws + WS_BAR) + XB_JOBCTR(8 + l * 24);
  volatile int* sjob = (volatile int*)(lds + LDS_BYTES - 16);
  for (int tile = blockIdx.x; tile < 96 * 26; tile += gridDim.x) {
    const int rt = tile / 26, ct = tile % 26;
    const int row0 = rt * 128, col0 = ct * 128;
    f32x4 acc[4][4];
#pragma unroll
    for (int i = 0; i < 4; ++i)
#pragma unroll
      for (int j = 0; j < 4; ++j) acc[i][j] = (f32x4){0.f, 0.f, 0.f, 0.f};
    const bool vtile = (col0 >= 1536 && col0 < 1792) || (col0 >= 2560 && col0 < 2816) || col0 >= 3200;
    const int cw = col0 + wn * 64;
    const int rw = row0 + wm * 64;
    const bool sample = row0 >= T_PR;
    int b, pbase, L;
    if (!sample) { b = rw >> 8; pbase = rw & 255; L = 256; }
    else { b = (rw - T_PR) >> 10; pbase = (rw - T_PR) & 1023; L = 1024; }
    if (vtile) {
      gemm_accum<4, true, false>(acc, hb + (size_t)row0 * 1024, 1024, wt + (size_t)col0 * 1024, 1024, 1024, As, Bs);
      int vkind, vhead, vnh = 4;
      if (cw < 1792) { vkind = 0; vhead = (cw - 1536) >> 6; }
      else if (cw < 2816) { vkind = 1; vhead = (cw - 2560) >> 6; }
      else { vkind = 2; vhead = (cw - 3200) >> 6; vnh = 2; }
      bf16_t* vt = (bf16_t*)(p.ws + (vkind == 0 ? WS_AVT : vkind == 1 ? WS_CVT : WS_DVT));
      const size_t base = sample ? (size_t)16 * vnh * 64 * 256 + (size_t)(b * vnh + vhead) * 64 * 1024 : (size_t)(b * vnh + vhead) * 64 * 256;
#pragma unroll
      for (int mi = 0; mi < 4; ++mi)
#pragma unroll
        for (int ni = 0; ni < 4; ++ni) {
          const int d = ni * 16 + c16;
          uint2 o;
          o.x = pack2(acc[mi][ni][0], acc[mi][ni][1]);
          o.y = pack2(acc[mi][ni][2], acc[mi][ni][3]);
          *(uint2*)(vt + base + (size_t)d * L + pbase + mi * 16 + g * 4) = o;
        }
      if (!sample) {
        float* ob = p.out + (vkind == 0 ? O_DV : vkind == 1 ? O_NV : O_SV) + (size_t)((b * 2 + l) * vnh + vhead) * 256 * 64;
#pragma unroll
        for (int mi = 0; mi < 4; ++mi)
#pragma unroll
          for (int i = 0; i < 4; ++i) {
            const int pos = pbase + mi * 16 + g * 4 + i;
#pragma unroll
            for (int ni = 0; ni < 4; ++ni) ob[(size_t)pos * 64 + ni * 16 + c16] = acc[mi][ni][i];
          }
      }
    } else {
      gemm_accum<4, true, true>(acc, hb + (size_t)row0 * 1024, 1024, wt + (size_t)col0 * 1024, 1024, 1024, As, Bs);
      const bool ropeA = sample && cw >= 1024 && cw < 1536;
      const bool ropeD = sample && cw >= 2816 && cw < 3200;
      if (ropeA) {
#pragma unroll
        for (int i = 0; i < 4; ++i) {
          const int pos = pbase + i * 16 + c16;
          const int prow = pos >> 6, pcol = pos & 63;
#pragma unroll
          for (int j = 0; j < 4; ++j)
#pragma unroll
            for (int r = 0; r < 4; ++r) {
              const float2 cs = tabA[((j & 1) ? pcol : prow) * 8 + (g & 1) * 4 + r];
              const float own = acc[i][j][r];
              const float oth = __shfl_xor(own, 32);
              acc[i][j][r] = (g < 2) ? (own * cs.x - oth * cs.y) : (oth * cs.y + own * cs.x);
            }
        }
      } else if (ropeD) {
#pragma unroll
        for (int i = 0; i < 4; ++i) {
          const int pos = pbase + i * 16 + c16;
          const int prow = pos >> 6, pcol = pos & 63;
#pragma unroll
          for (int r = 0; r < 4; ++r) {
            {
              const float2 cs = tabD[prow * 16 + g * 4 + r];
              const float x1 = acc[i][0][r], x2 = acc[i][1][r];
              acc[i][0][r] = x1 * cs.x - x2 * cs.y;
              acc[i][1][r] = x1 * cs.y + x2 * cs.x;
            }
            {
              const float2 cs = tabD[pcol * 16 + g * 4 + r];
              const float x1 = acc[i][2][r], x2 = acc[i][3][r];
              acc[i][2][r] = x1 * cs.x - x2 * cs.y;
              acc[i][3][r] = x1 * cs.y + x2 * cs.x;
            }
          }
        }
      }
#pragma unroll
      for (int i = 0; i < 4; ++i) {
        const size_t r = (size_t)(rw + i * 16 + c16);
#pragma unroll
        for (int j = 0; j < 4; j += 2) {
          const unsigned ax = pack2(acc[i][j][0], acc[i][j][1]), ay = pack2(acc[i][j][2], acc[i][j][3]);
          const unsigned bx = pack2(acc[i][j + 1][0], acc[i][j + 1][1]), by = pack2(acc[i][j + 1][2], acc[i][j + 1][3]);
          auto sx = __builtin_amdgcn_permlane16_swap(ax, bx, false, false);
          auto sy = __builtin_amdgcn_permlane16_swap(ay, by, false, false);
          uint4 o;
          o.x = sx[0]; o.y = sy[0]; o.z = sx[1]; o.w = sy[1];
          const int col = cw + (j + (g & 1)) * 16 + (g & 2) * 4;
          *(uint4*)(hin + r * INW + col) = o;
        }
      }
      if (!sample) {
        float* ob = nullptr;
        int kind = -1;
        if (cw >= 1280 && cw < 1536) { kind = 0; ob = p.out + O_DK + ((size_t)((b * 2 + l) * 4 + ((cw - 1280) >> 6)) * 2) * 256 * 32; }
        else if (cw >= 2304 && cw < 2560) { kind = 1; ob = p.out + O_NK + (size_t)((b * 2 + l) * 4 + ((cw - 2304) >> 6)) * 256 * 64; }
        else if (cw >= 3072 && cw < 3200) { kind = 1; ob = p.out + O_SK + (size_t)((b * 2 + l) * 2 + ((cw - 3072) >> 6)) * 256 * 64; }
        if (kind == 0) {
#pragma unroll
          for (int i = 0; i < 4; ++i) {
            const int pos = pbase + i * 16 + c16;
#pragma unroll
            for (int j = 0; j < 4; ++j) {
              const float4 o = {acc[i][j][0], acc[i][j][1], acc[i][j][2], acc[i][j][3]};
              *(float4*)(ob + ((size_t)(j >> 1) * 256 + pos) * 32 + (j & 1) * 16 + g * 4) = o;
            }
          }
        } else if (kind == 1) {
#pragma unroll
          for (int i = 0; i < 4; ++i) {
            const int pos = pbase + i * 16 + c16;
#pragma unroll
            for (int j = 0; j < 4; ++j) {
              const float4 o = {acc[i][j][0], acc[i][j][1], acc[i][j][2], acc[i][j][3]};
              *(float4*)(ob + (size_t)pos * 64 + j * 16 + g * 4) = o;
            }
          }
        }
      }
    }
  }
}

__device__ void phase_merge(const Params& p, int l, unsigned char* lds) {
  bf16_t* As = (bf16_t*)lds;
  bf16_t* Bs = As + 128 * LDT;
  const bf16_t* hb = (const bf16_t*)(p.ws + WS_H);
  const bf16_t* br = (const bf16_t*)(p.ws + WS_BR);
  const bf16_t* wmg = (const bf16_t*)(p.ws + WS_WMG) + (size_t)l * 4096 * 1024;
  const bf16_t* wbo = (const bf16_t*)(p.ws + WS_WBO) + (size_t)l * 4 * 1024 * 256;
  bf16_t* mb = (bf16_t*)(p.ws + WS_MB);
  unsigned* ctrs = (unsigned*)(p.ws + WS_BAR) + XB_JOBCTR(16 + l * 24);
  volatile int* sjob = (volatile int*)(lds + LDS_BYTES - 16);
  for (int tile = blockIdx.x; tile < 96 * 8; tile += gridDim.x) {
    const int rt = tile >> 3, ct = tile & 7;
    const int row0 = rt * 128, col0 = ct * 128;
    f32x4 macc[4][4];
#pragma unroll
    for (int i = 0; i < 4; ++i)
#pragma unroll
      for (int j = 0; j < 4; ++j) macc[i][j] = (f32x4){0.f, 0.f, 0.f, 0.f};
#pragma unroll 1
    for (int n = 0; n < 4; ++n) {
      uint2 gp[4][4];
      {
        f32x4 G[4][4];
#pragma unroll
        for (int i = 0; i < 4; ++i)
#pragma unroll
          for (int j = 0; j < 4; ++j) G[i][j] = (f32x4){0.f, 0.f, 0.f, 0.f};
        gemm_accum<4, false, true>(G, hb + (size_t)row0 * 1024, 1024, wmg + (size_t)(n * 1024 + col0) * 1024, 1024, 1024, As, Bs);
        const int lane1 = TIDX & 63, wn1 = (TIDX >> 6) & 1, g1 = lane1 >> 4;
#pragma unroll
        for (int j = 0; j < 4; ++j) {
          const float4 bb = *(const float4*)(p.b_mg + (size_t)l * 4096 + n * 1024 + col0 + wn1 * 64 + j * 16 + g1 * 4);
#pragma unroll
          for (int i = 0; i < 4; ++i) {
            gp[i][j].x = pack2(sigmoidf_(G[i][j][0] + bb.x), sigmoidf_(G[i][j][1] + bb.y));
            gp[i][j].y = pack2(sigmoidf_(G[i][j][2] + bb.z), sigmoidf_(G[i][j][3] + bb.w));
          }
        }
      }
#pragma unroll
      for (int hh = 0; hh < 2; ++hh) {
        f32x4 Pa[4][2];
#pragma unroll
        for (int i = 0; i < 4; ++i)
#pragma unroll
          for (int j = 0; j < 2; ++j) Pa[i][j] = (f32x4){0.f, 0.f, 0.f, 0.f};
        gemm_accum<2, true, true>(Pa, br + (size_t)row0 * 1024 + n * 256, 1024, wbo + (size_t)(n * 1024 + col0 + hh * 32) * 256, 256, 256, As, Bs, 64);
#pragma unroll
        for (int i = 0; i < 4; ++i)
#pragma unroll
          for (int j = 0; j < 2; ++j) {
            macc[i][hh * 2 + j][0] += lo2f(gp[i][hh * 2 + j].x) * Pa[i][j][0];
            macc[i][hh * 2 + j][1] += hi2f(gp[i][hh * 2 + j].x) * Pa[i][j][1];
            macc[i][hh * 2 + j][2] += lo2f(gp[i][hh * 2 + j].y) * Pa[i][j][2];
            macc[i][hh * 2 + j][3] += hi2f(gp[i][hh * 2 + j].y) * Pa[i][j][3];
          }
      }
    }
    const int lane = TIDX & 63, wave = TIDX >> 6, wm = wave >> 1, wn = wave & 1, g = lane >> 4, c16 = lane & 15;
#pragma unroll
    for (int i = 0; i < 4; ++i) {
      const size_t r = (size_t)(row0 + wm * 64 + i * 16 + c16);
#pragma unroll
      for (int j = 0; j < 4; ++j) {
        uint2 o;
        o.x = pack2(macc[i][j][0], macc[i][j][1]);
        o.y = pack2(macc[i][j][2], macc[i][j][3]);
        *(uint2*)(mb + r * 1024 + col0 + wn * 64 + j * 16 + g * 4) = o;
      }
    }
  }
}

__device__ void phase_out(const Params& p, int l, unsigned char* lds) {
  bf16_t* As = (bf16_t*)lds;
  bf16_t* Bs = As + 128 * LDT;
  const bf16_t* mb = (const bf16_t*)(p.ws + WS_MB);
  const bf16_t* wo = (const bf16_t*)(p.ws + WS_WO) + (size_t)l * 1024 * 1024;
  const float* modl = (const float*)(p.ws + WS_MOD) + (size_t)l * 9 * 3072;
  const int lane = TIDX & 63, wave = TIDX >> 6, wm = wave >> 1, wn = wave & 1, g = lane >> 4, c16 = lane & 15;
  unsigned* ctrs = (unsigned*)(p.ws + WS_BAR) + XB_JOBCTR(24 + l * 24);
  volatile int* sjob = (volatile int*)(lds + LDS_BYTES - 16);
  for (int tile = blockIdx.x; tile < 96 * 8; tile += gridDim.x) {
    const int rt = tile >> 3, ct = tile & 7;
    const int row0 = rt * 128, col0 = ct * 128;
    f32x4 acc[4][4];
#pragma unroll
    for (int i = 0; i < 4; ++i)
#pragma unroll
      for (int j = 0; j < 4; ++j) acc[i][j] = (f32x4){0.f, 0.f, 0.f, 0.f};
    gemm_accum<4, true, true>(acc, mb + (size_t)row0 * 1024, 1024, wo + (size_t)col0 * 1024, 1024, 1024, As, Bs);
    const int v = row0 < T_PR ? 0 : 1 + ((row0 - T_PR) >> 10);
    const float* gate = modl + v * 3072 + 2048;
#pragma unroll
    for (int j = 0; j < 4; ++j) {
      const int col = col0 + wn * 64 + j * 16 + g * 4;
      const float4 gt = *(const float4*)(gate + col);
#pragma unroll
      for (int i = 0; i < 4; ++i) {
        const int t = row0 + wm * 64 + i * 16 + c16;
        const float4 xo = *(const float4*)(xrow(p, l, t) + col);
        float4 o;
        o.x = xo.x + gt.x * acc[i][j][0];
        o.y = xo.y + gt.y * acc[i][j][1];
        o.z = xo.z + gt.z * acc[i][j][2];
        o.w = xo.w + gt.w * acc[i][j][3];
        *(float4*)(p.out + O_Y + (size_t)t * 1024 + col) = o;
      }
    }
  }
}

template <int NM, int MODE>
__device__ __forceinline__ void attn_chunk(const bf16_t* Ks, const bf16_t* Vts, int koff, const bf16x8 (&qf)[2], float scale,
                                           float (&m_run)[NM], float (&l_run)[NM], f32x4 (&o)[NM][4], int lane,
                                           int qa, int qb, int ka, const float* rpbh) {
  const int g = lane >> 4, r16 = lane & 15;
  f32x4 s[NM][2];
#pragma unroll
  for (int kt = 0; kt < 2; ++kt) {
    const bf16_t* kp = Ks + (koff + kt * 16 + r16) * LDT + g * 8;
    const bf16x8 k0 = *(const bf16x8*)kp;
    const bf16x8 k1 = *(const bf16x8*)(kp + 32);
    const f32x4 z = {0.f, 0.f, 0.f, 0.f};
    if (NM == 2) {
      s[0][kt] = mfma16(k0, qf[0], z);
      s[NM - 1][kt] = mfma16(k1, qf[1], z);
    } else {
      s[0][kt] = mfma16(k1, qf[1], mfma16(k0, qf[0], z));
    }
  }
  bool valid[2][4];
  float bias[2][4];
#pragma unroll
  for (int kt = 0; kt < 2; ++kt)
#pragma unroll
    for (int i = 0; i < 4; ++i) {
      valid[kt][i] = true;
      bias[kt][i] = 0.f;
      const int kk = koff + kt * 16 + g * 4 + i;
      if (MODE == 1) {
        int cs = qb - 8;
        cs = cs < 0 ? 0 : (cs > 48 ? 48 : cs);
        const bool ok = (kk >= cs) && (kk < cs + 16);
        valid[kt][i] = ok;
        int dc = kk - qb + 15;
        dc = dc < 0 ? 0 : (dc > 30 ? 30 : dc);
        bias[kt][i] = rpbh[(ka - qa + 7) * 31 + dc] * 1.4426950408889634f;
      } else if (MODE == 2) {
        const int kp = ka + kt * 16 + g * 4 + i;
        int df = qa - kp;
        df = df < 0 ? -df : df;
        valid[kt][i] = df <= 128;
      }
    }
  bf16x8 pb[NM];
#pragma unroll
  for (int m = 0; m < NM; ++m) {
    float x[2][4];
    float mx = -1e30f;
#pragma unroll
    for (int kt = 0; kt < 2; ++kt)
#pragma unroll
      for (int i = 0; i < 4; ++i) {
        float xv = MODE == 1 ? fmaf(s[m][kt][i], scale, bias[kt][i]) : s[m][kt][i] * scale;
        if (MODE != 0) xv = valid[kt][i] ? xv : -1e30f;
        x[kt][i] = xv;
        mx = fmaxf(mx, xv);
      }
    mx = rowmax4(mx);
    const float mn = fmaxf(m_run[m], mx);
    const float alpha = __builtin_amdgcn_exp2f(m_run[m] - mn);
    m_run[m] = mn;
    float ps = 0.f;
    float pv[8];
#pragma unroll
    for (int kt = 0; kt < 2; ++kt)
#pragma unroll
      for (int i = 0; i < 4; ++i) {
        float e = __builtin_amdgcn_exp2f(x[kt][i] - mn);
        if (MODE != 0) e = valid[kt][i] ? e : 0.f;
        pv[kt * 4 + i] = e;
        ps += e;
      }
    l_run[m] = l_run[m] * alpha + ps;
#pragma unroll
    for (int dt = 0; dt < 4; ++dt) {
      o[m][dt][0] *= alpha;
      o[m][dt][1] *= alpha;
      o[m][dt][2] *= alpha;
      o[m][dt][3] *= alpha;
    }
    union { bf16x8 v; unsigned u[4]; } pk;
    pk.u[0] = pack2(pv[0], pv[1]);
    pk.u[1] = pack2(pv[2], pv[3]);
    pk.u[2] = pack2(pv[4], pv[5]);
    pk.u[3] = pack2(pv[6], pv[7]);
    pb[m] = pk.v;
  }
#pragma unroll
  for (int dt = 0; dt < 4; ++dt) {
    const bf16_t* vp = Vts + (dt * 16 + r16) * LDV + koff + g * 4;
    union { bf16x8 v; uint2 u[2]; } vf;
    vf.u[0] = *(const uint2*)vp;
    vf.u[1] = *(const uint2*)(vp + 16);
#pragma unroll
    for (int m = 0; m < NM; ++m) o[m][dt] = mfma16(vf.v, pb[m], o[m][dt]);
  }
}

template <int NM, int MODE>
__device__ __forceinline__ void attn_tile64(const bf16_t* Ks, const bf16_t* Vts, const bf16x8 (&qf)[2],
                                            float (&m_run)[NM], float (&l_run)[NM], f32x4 (&o)[NM][4], int lane, int qa, int ka,
                                            bool first) {
  const int g = lane >> 4, r16 = lane & 15;
  f32x4 s[NM][4];
  f32x4 ci[NM];
#pragma unroll
  for (int m = 0; m < NM; ++m) {
    const float c = first ? 0.f : -m_run[m];
    ci[m] = (f32x4){c, c, c, c};
  }
#pragma unroll
  for (int kt = 0; kt < 4; ++kt) {
    const bf16_t* kp = Ks + (kt * 16 + r16) * LDT + g * 8;
    const bf16x8 k0 = *(const bf16x8*)kp;
    const bf16x8 k1 = *(const bf16x8*)(kp + 32);
    if (NM == 2) {
      s[0][kt] = mfma16(k0, qf[0], ci[0]);
      s[NM - 1][kt] = mfma16(k1, qf[1], ci[NM - 1]);
    } else {
      s[0][kt] = mfma16(k1, qf[1], mfma16(k0, qf[0], ci[0]));
    }
  }
  if (MODE == 2) {
#pragma unroll
    for (int kt = 0; kt < 4; ++kt)
#pragma unroll
      for (int i = 0; i < 4; ++i) {
        int df = qa - (ka + kt * 16 + g * 4 + i);
        df = df < 0 ? -df : df;
        const bool ok = df <= 128;
#pragma unroll
        for (int m = 0; m < NM; ++m) s[m][kt][i] = ok ? s[m][kt][i] : -1e30f;
      }
  }
  bf16x8 pbA[NM], pbB[NM];
#pragma unroll
  for (int m = 0; m < NM; ++m) {
    float mx = fmaxf(fmaxf(fmaxf(s[m][0][0], s[m][0][1]), fmaxf(s[m][0][2], s[m][0][3])),
                     fmaxf(fmaxf(s[m][1][0], s[m][1][1]), fmaxf(s[m][1][2], s[m][1][3])));
    mx = fmaxf(mx, fmaxf(fmaxf(fmaxf(s[m][2][0], s[m][2][1]), fmaxf(s[m][2][2], s[m][2][3])),
                         fmaxf(fmaxf(s[m][3][0], s[m][3][1]), fmaxf(s[m][3][2], s[m][3][3]))));
    mx = rowmax4(mx);
    if (first || __any(mx > 0.f)) {
      const float d = first ? mx : fmaxf(mx, 0.f);
      const float alpha = first ? 0.f : __builtin_amdgcn_exp2f(-d);
      m_run[m] = first ? d : m_run[m] + d;
      l_run[m] *= alpha;
#pragma unroll
      for (int dt = 0; dt < 4; ++dt) o[m][dt] *= alpha;
#pragma unroll
      for (int kt = 0; kt < 4; ++kt) s[m][kt] -= d;
    }
    f32x4 ps4 = {0.f, 0.f, 0.f, 0.f};
#pragma unroll
    for (int kt = 0; kt < 4; ++kt) {
      s[m][kt][0] = __builtin_amdgcn_exp2f(s[m][kt][0]);
      s[m][kt][1] = __builtin_amdgcn_exp2f(s[m][kt][1]);
      s[m][kt][2] = __builtin_amdgcn_exp2f(s[m][kt][2]);
      s[m][kt][3] = __builtin_amdgcn_exp2f(s[m][kt][3]);
      ps4 += s[m][kt];
    }
    l_run[m] += (ps4[0] + ps4[1]) + (ps4[2] + ps4[3]);
    union { bf16x8 v; unsigned u[4]; } pk;
    pk.u[0] = pack2(s[m][0][0], s[m][0][1]);
    pk.u[1] = pack2(s[m][0][2], s[m][0][3]);
    pk.u[2] = pack2(s[m][1][0], s[m][1][1]);
    pk.u[3] = pack2(s[m][1][2], s[m][1][3]);
    pbA[m] = pk.v;
    pk.u[0] = pack2(s[m][2][0], s[m][2][1]);
    pk.u[1] = pack2(s[m][2][2], s[m][2][3]);
    pk.u[2] = pack2(s[m][3][0], s[m][3][1]);
    pk.u[3] = pack2(s[m][3][2], s[m][3][3]);
    pbB[m] = pk.v;
  }
#pragma unroll
  for (int dt = 0; dt < 4; ++dt) {
    const bf16_t* vp = Vts + (dt * 16 + r16) * LDV + g * 4;
    union { bf16x8 v; uint2 u[2]; } vfA, vfB;
    vfA.u[0] = *(const uint2*)vp;
    vfA.u[1] = *(const uint2*)(vp + 16);
    vfB.u[0] = *(const uint2*)(vp + 32);
    vfB.u[1] = *(const uint2*)(vp + 48);
#pragma unroll
    for (int m = 0; m < NM; ++m) {
      o[m][dt] = mfma16(vfA.v, pbA[m], o[m][dt]);
      o[m][dt] = mfma16(vfB.v, pbB[m], o[m][dt]);
    }
  }
}

template <int BR, bool SAMPLE, int QG>
__device__ void attn_job(const Params& p, int l, int b, int head, int qp, unsigned char* lds) {
  constexpr int L = SAMPLE ? 1024 : 256;
  constexpr int NM = BR == 0 ? 2 : 1;
  constexpr int QCOL = BR == 0 ? 1024 : (BR == 2 ? 2048 : 2816);
  constexpr int KCOL = BR == 0 ? 1280 : (BR == 2 ? 2304 : 3072);
  constexpr int GCOL = BR == 0 ? 0 : (BR == 2 ? 512 : 768);
  constexpr int NKH = BR == 3 ? 2 : 4;
  bf16_t* Ks = (bf16_t*)lds;
  bf16_t* Vts = Ks + 64 * LDT;
  const int tid = TIDX, lane = tid & 63, w = tid >> 6, g = lane >> 4, qi = lane & 15;
  const int t0 = SAMPLE ? T_PR + b * 1024 : b * 256;
  int qpos[QG], tq[QG];
#pragma unroll
  for (int gq = 0; gq < QG; ++gq) {
    qpos[gq] = (QG * qp + gq) * 64 + w * 16 + qi;
    tq[gq] = t0 + qpos[gq];
  }
  const bf16_t* hin = (const bf16_t*)(p.ws + WS_HIN);
  const int kvh = BR == 3 ? (head >> 1) : head;
  const int kcol = KCOL + kvh * 64;
  const bf16_t* vT = (const bf16_t*)(p.ws + (BR == 0 ? WS_AVT : (BR == 2 ? WS_CVT : WS_DVT))) +
                     (SAMPLE ? (size_t)16 * NKH * 64 * 256 + (size_t)(b * NKH + kvh) * 64 * 1024 : (size_t)(b * NKH + kvh) * 64 * 256);
  const int cmat = (b * 2 + l) * NKH + kvh;
  const bf16_t* cvt = (const bf16_t*)(p.ws + (BR == 0 ? WS_CVA : (BR == 2 ? WS_CVC : WS_CVD))) + (size_t)cmat * 64 * 512;
  bf16x8 qf[QG][2];
  float m_run[QG][NM], l_run[QG][NM];
  f32x4 o[QG][NM][4];
#pragma unroll
  for (int gq = 0; gq < QG; ++gq) {
    qf[gq][0] = *(const bf16x8*)(hin + (size_t)tq[gq] * INW + QCOL + head * 64 + g * 8);
    qf[gq][1] = *(const bf16x8*)(hin + (size_t)tq[gq] * INW + QCOL + head * 64 + 32 + g * 8);
    const float qs = (BR == 0 ? 0.17677669529663687f : 0.125f) * 1.4426950408889634f;
#pragma unroll
    for (int i = 0; i < 2; ++i) {
      union { bf16x8 v; unsigned u[4]; } t;
      t.v = qf[gq][i];
#pragma unroll
      for (int w2 = 0; w2 < 4; ++w2) t.u[w2] = pack2(lo2f(t.u[w2]) * qs, hi2f(t.u[w2]) * qs);
      qf[gq][i] = t.v;
    }
#pragma unroll
    for (int m = 0; m < NM; ++m) {
      m_run[gq][m] = -1e30f;
      l_run[gq][m] = 0.f;
#pragma unroll
      for (int dt = 0; dt < 4; ++dt) o[gq][m][dt] = (f32x4){0.f, 0.f, 0.f, 0.f};
    }
    if (BR == 3) {
      m_run[gq][0] = p.sink[l * 4 + head] * 1.4426950408889634f;
      l_run[gq][0] = (g == 0) ? 1.f : 0.f;
    }
  }
  const float scale = 1.f;
  const int nctx = SAMPLE ? 8 : 0;
  int loc0 = 0, nloc = 4;
  int glo[QG], ghi[QG];
#pragma unroll
  for (int gq = 0; gq < QG; ++gq) { glo[gq] = 0; ghi[gq] = 3; }
  if (SAMPLE) {
#pragma unroll
    for (int gq = 0; gq < QG; ++gq) {
      const int qtg = QG * qp + gq;
      if (BR == 0) { glo[gq] = 0; ghi[gq] = 15; }
      else if (BR == 2) { int rs = qtg - 4; rs = rs < 0 ? 0 : (rs > 8 ? 8 : rs); glo[gq] = rs; ghi[gq] = rs + 7; }
      else { glo[gq] = qtg - 2 < 0 ? 0 : qtg - 2; ghi[gq] = qtg + 2 > 15 ? 15 : qtg + 2; }
    }
    loc0 = glo[0];
    nloc = ghi[QG - 1] - glo[0] + 1;
  }
  const float* rpbh = p.rpb + (size_t)(l * 4 + head) * 15 * 31;
  const int nb = w * 16 - 8;
  const int boff = nb < 0 ? 0 : (nb > 32 ? 32 : nb);
  const int ntl = nctx + nloc;
  const int skey = tid >> 2, sseg = tid & 3;
  float4 kr0 = make_float4(0.f, 0.f, 0.f, 0.f), kr1 = kr0, kr2 = kr0, kr3 = kr0;
  uint4 vr0, vr1;
#define ATT_ISSUE(IT2)                                                                                                   \
  {                                                                                                                      \
    const int it2_ = (IT2);                                                                                              \
    const bool c2 = it2_ < nctx;                                                                                         \
    const int kt2 = c2 ? it2_ : loc0 + (it2_ - nctx);                                                                    \
    if (c2) {                                                                                                            \
      const float* src;                                                                                                  \
      if (BR == 0) src = p.cdk + ((((size_t)(b * 2 + l) * 4 + head) * 2 + (sseg >> 1)) * 512 + kt2 * 64 + skey) * 32 + (sseg & 1) * 16; \
      else if (BR == 2) src = p.cnk + (((size_t)(b * 2 + l) * 4 + head) * 512 + kt2 * 64 + skey) * 64 + sseg * 16;      \
      else src = p.csk + (((size_t)(b * 2 + l) * 2 + kvh) * 512 + kt2 * 64 + skey) * 64 + sseg * 16;                     \
      kr0 = ((const float4*)src)[0];                                                                                     \
      kr1 = ((const float4*)src)[1];                                                                                     \
      kr2 = ((const float4*)src)[2];                                                                                     \
      kr3 = ((const float4*)src)[3];                                                                                     \
    } else {                                                                                                             \
      const bf16_t* src = hin + (size_t)(t0 + kt2 * 64 + skey) * INW + kcol + sseg * 16;                                 \
      kr0 = ((const float4*)src)[0];                                                                                     \
      kr1 = ((const float4*)src)[1];                                                                                     \
    }                                                                                                                    \
    const bf16_t* vsrc = c2 ? cvt + (size_t)skey * 512 + kt2 * 64 + sseg * 16 : vT + (size_t)skey * L + kt2 * 64 + sseg * 16; \
    vr0 = ((const uint4*)vsrc)[0];                                                                                       \
    vr1 = ((const uint4*)vsrc)[1];                                                                                       \
  }
#define ATT_WRITE(CTX, KB, VB)                                                                                        \
  {                                                                                                                      \
    uint4 u0, u1;                                                                                                        \
    if (CTX) {                                                                                                           \
      u0.x = pack2(kr0.x, kr0.y); u0.y = pack2(kr0.z, kr0.w); u0.z = pack2(kr1.x, kr1.y); u0.w = pack2(kr1.z, kr1.w);    \
      u1.x = pack2(kr2.x, kr2.y); u1.y = pack2(kr2.z, kr2.w); u1.z = pack2(kr3.x, kr3.y); u1.w = pack2(kr3.z, kr3.w);    \
    } else {                                                                                                             \
      u0 = __builtin_bit_cast(uint4, kr0);                                                                               \
      u1 = __builtin_bit_cast(uint4, kr1);                                                                               \
    }                                                                                                                    \
    *(uint4*)((KB) + skey * LDT + sseg * 16) = u0;                                                                       \
    *(uint4*)((KB) + skey * LDT + sseg * 16 + 8) = u1;                                                                   \
    *(uint4*)((VB) + skey * LDV + sseg * 16) = vr0;                                                                      \
    *(uint4*)((VB) + skey * LDV + sseg * 16 + 8) = vr1;                                                                  \
  }
  constexpr int KVB = 64 * LDT + 64 * LDV;
  __syncthreads();
  ATT_ISSUE(0)
  ATT_WRITE(0 < nctx, Ks, Vts)
  if (1 < ntl) ATT_ISSUE(1)
  __syncthreads();
  for (int it = 0; it < ntl; ++it) {
    const bool isctx = it < nctx;
    const int kt = isctx ? it : loc0 + (it - nctx);
    const bf16_t* Kc = Ks + (it & 1) * KVB;
    const bf16_t* Vc = Vts + (it & 1) * KVB;
    if (it + 1 < ntl) ATT_WRITE(it + 1 < nctx, Ks + ((it + 1) & 1) * KVB, Vts + ((it + 1) & 1) * KVB)
    if (it + 2 < ntl) ATT_ISSUE(it + 2)
    __builtin_amdgcn_sched_barrier(0);
#pragma unroll
    for (int gq = 0; gq < QG; ++gq) {
      if (!isctx && (kt < glo[gq] || kt > ghi[gq])) continue;
      if (SAMPLE && BR == 2 && !isctx) {
        attn_chunk<NM, 1>(Kc, Vc, boff, qf[gq], scale, m_run[gq], l_run[gq], o[gq], lane, QG * qp + gq, w * 16 + qi, kt, rpbh);
      } else if (SAMPLE && BR == 3 && !isctx) {
        attn_tile64<NM, 2>(Kc, Vc, qf[gq], m_run[gq], l_run[gq], o[gq], lane, qpos[gq], kt * 64, false);
      } else {
        attn_tile64<NM, 0>(Kc, Vc, qf[gq], m_run[gq], l_run[gq], o[gq], lane, 0, 0, BR != 3 && it == 0);
      }
    }
    __syncthreads();
  }
#undef ATT_WRITE
  float lam = 0.f, lam_init = 0.f;
  if (BR == 0) {
    float s01 = 0.f, s23 = 0.f;
    for (int e = 0; e < 32; ++e) {
      s01 += p.dlam[l * 128 + e] * p.dlam[l * 128 + 32 + e];
      s23 += p.dlam[l * 128 + 64 + e] * p.dlam[l * 128 + 96 + e];
    }
    lam_init = 0.8f - 0.6f * expf(-0.3f * (float)l);
    lam = expf(s01) - expf(s23) + lam_init;
  }
  bf16_t* br = (bf16_t*)(p.ws + WS_BR);
#pragma unroll
  for (int gq = 0; gq < QG; ++gq) {
    float linv[NM];
#pragma unroll
    for (int m = 0; m < NM; ++m) {
      float lt = l_run[gq][m];
      lt += __shfl_xor(lt, 16);
      lt += __shfl_xor(lt, 32);
      linv[m] = 1.f / lt;
    }
    float y[4][4];
    if (BR == 0) {
      float ss = 0.f;
#pragma unroll
      for (int dt = 0; dt < 4; ++dt)
#pragma unroll
        for (int i = 0; i < 4; ++i) {
          float v = o[gq][0][dt][i] * linv[0] - lam * (o[gq][NM - 1][dt][i] * linv[NM - 1]);
          y[dt][i] = v;
          ss += v * v;
        }
      ss += __shfl_xor(ss, 16);
      ss += __shfl_xor(ss, 32);
      const float rinv = rsqrtf(ss * (1.f / 64.f) + 1e-6f) * (1.f - lam_init);
#pragma unroll
      for (int dt = 0; dt < 4; ++dt)
#pragma unroll
        for (int i = 0; i < 4; ++i) y[dt][i] *= rinv * p.dg[l * 64 + dt * 16 + g * 4 + i];
    } else {
#pragma unroll
      for (int dt = 0; dt < 4; ++dt)
#pragma unroll
        for (int i = 0; i < 4; ++i) y[dt][i] = o[gq][0][dt][i] * linv[0];
    }
#pragma unroll
    for (int dt = 0; dt < 4; ++dt) {
      const int d = dt * 16 + g * 4;
      const uint2 gv = *(const uint2*)(hin + (size_t)tq[gq] * INW + GCOL + head * 64 + d);
      uint2 ov;
      ov.x = pack2(y[dt][0] * siluf_(lo2f(gv.x)), y[dt][1] * siluf_(hi2f(gv.x)));
      ov.y = pack2(y[dt][2] * siluf_(lo2f(gv.y)), y[dt][3] * siluf_(hi2f(gv.y)));
      *(uint2*)(br + (size_t)tq[gq] * 1024 + GCOL + head * 64 + d) = ov;
    }
  }
}

__device__ void lru_job(const Params& p, int l, int seq, int n, int half, unsigned char* lds) {
  const bool sample = seq >= 16;
  const int b = sample ? seq - 16 : seq;
  const int L = sample ? 1024 : 256;
  const int t0 = sample ? T_PR + b * 1024 : b * 256;
  const int tid = TIDX, dir = tid >> 7, gt = tid & 127, gw = (tid >> 6) & 1, lane = tid & 63, g = lane >> 4, c16 = lane & 15;
  unsigned char* base = lds + dir * 26112;
  bf16_t* bxs = (bf16_t*)base;
  bf16_t* xcb = (bf16_t*)(base + 4480);
  float* xcf = (float*)(base + 4480 + 5120);
  float* af = (float*)(base + 4480 + 5120 + 8192);
  const bf16_t* hin = (const bf16_t*)(p.ws + WS_HIN);
  const bf16_t* wl = (const bf16_t*)(p.ws + WS_WLRU) + (size_t)(((l * 2 + dir) * 4 + n) * 2) * 4096;
  bf16x8 wf[2][2][2];
#pragma unroll
  for (int gate = 0; gate < 2; ++gate)
#pragma unroll
    for (int kk = 0; kk < 2; ++kk)
#pragma unroll
      for (int ks = 0; ks < 2; ++ks)
        wf[gate][kk][ks] = *(const bf16x8*)(wl + (size_t)gate * 4096 + ((2 * gw + kk) * 16 + c16) * 64 + ks * 32 + g * 8);
  float ba[2], bx[2], sp[2];
#pragma unroll
  for (int kk = 0; kk < 2; ++kk) {
    const int ch = n * 64 + (2 * gw + kk) * 16 + c16;
    ba[kk] = p.lru_ba[(l * 2 + dir) * 256 + ch];
    bx[kk] = p.lru_bx[(l * 2 + dir) * 256 + ch];
    const float lm = p.lru_lam[(l * 2 + dir) * 256 + ch];
    sp[kk] = -8.f * log1pf(expf(-lm));
  }
  const int cch = n * 64 + lane;
  const float cw0 = p.conv_w[(l * 4 + 0) * 256 + cch], cw1 = p.conv_w[(l * 4 + 1) * 256 + cch], cw2 = p.conv_w[(l * 4 + 2) * 256 + cch],
              cw3 = p.conv_w[(l * 4 + 3) * 256 + cch], cb = p.conv_b[l * 256 + cch];
  const bool split = half >= 0;
  const bool dep = split && (dir == 0 ? half == 1 : half == 0);
  float h = 0.f, pp = 1.f;
  if (sample && !dep) h = p.state[((size_t)(b * 2 + l) * 2 + dir) * 256 + n * 64 + lane];
  float* pbuf = (float*)(p.ws + WS_PB);
  float* yown = (float*)(p.ws + (dir == 0 ? WS_YF : WS_YB));
  const float* yoth = (const float*)(p.ws + (dir == 0 ? WS_YB : WS_YF));
  bf16_t* br = (bf16_t*)(p.ws + WS_BR);
  const int nch = split ? 16 : L / 32;
  const int c_lo = split ? half * 16 : 0;
  uint4 rw0, rw1, rw2;
#define LRU_ISSUE(CC)                                                                                               \
  {                                                                                                                    \
    const int cc_ = (CC);                                                                                              \
    {                                                                                                                  \
      const int idx = gt, r = idx >> 3, sg = idx & 7, pos = cc_ * 32 - 1 + r;                                          \
      const bool ok = pos >= 0 && pos < L;                                                                             \
      const int pc = ok ? pos : 0;                                                                                     \
      uint4 v = *(const uint4*)(hin + (size_t)(t0 + pc) * INW + 1792 + n * 64 + sg * 8);                               \
      rw0.x = ok ? v.x : 0u; rw0.y = ok ? v.y : 0u; rw0.z = ok ? v.z : 0u; rw0.w = ok ? v.w : 0u;                      \
    }                                                                                                                  \
    {                                                                                                                  \
      const int idx = gt + 128, r = idx >> 3, sg = idx & 7, pos = cc_ * 32 - 1 + r;                                    \
      const bool ok = pos >= 0 && pos < L;                                                                             \
      const int pc = ok ? pos : 0;                                                                                     \
      uint4 v = *(const uint4*)(hin + (size_t)(t0 + pc) * INW + 1792 + n * 64 + sg * 8);                               \
      rw1.x = ok ? v.x : 0u; rw1.y = ok ? v.y : 0u; rw1.z = ok ? v.z : 0u; rw1.w = ok ? v.w : 0u;                      \
    }                                                                                                                  \
    {                                                                                                                  \
      const int idx = gt + 256, r = idx >> 3, sg = idx & 7, pos = cc_ * 32 - 1 + r;                                    \
      const bool ok = idx < 280 && pos >= 0 && pos < L;                                                                \
      const int pc = ok ? pos : 0;                                                                                     \
      uint4 v = *(const uint4*)(hin + (size_t)(t0 + pc) * INW + 1792 + n * 64 + sg * 8);                               \
      rw2.x = ok ? v.x : 0u; rw2.y = ok ? v.y : 0u; rw2.z = ok ? v.z : 0u; rw2.w = ok ? v.w : 0u;                      \
    }                                                                                                                  \
  }
#define LRU_WRITE()                                                                         \
  {                                                                                         \
    *(uint4*)(bxs + (gt >> 3) * 64 + (gt & 7) * 8) = rw0;                                   \
    *(uint4*)(bxs + ((gt + 128) >> 3) * 64 + (gt & 7) * 8) = rw1;                           \
    if (gt + 256 < 280) *(uint4*)(bxs + ((gt + 256) >> 3) * 64 + (gt & 7) * 8) = rw2;       \
  }
  LRU_ISSUE(c_lo + (dir == 0 ? 0 : nch - 1))
  LRU_WRITE()
  for (int ci = 0; ci < nch; ++ci) {
    const int c = c_lo + (dir == 0 ? ci : nch - 1 - ci);
    const bool combine = !split && ci >= (nch >> 1);
    __syncthreads();
    if (ci + 1 < nch) LRU_ISSUE(dir == 0 ? c + 1 : c - 1)
    float4 py[4];
    uint2 pg[4];
    if (combine) {
#pragma unroll
      for (int q = 0; q < 4; ++q) {
        const int idx = gt + 128 * q, tok = idx >> 4, c4 = (idx & 15) * 4;
        const size_t t = (size_t)(t0 + c * 32 + tok);
        py[q] = *(const float4*)(yoth + t * 256 + n * 64 + c4);
        pg[q] = *(const uint2*)(hin + t * INW + 256 + n * 64 + c4);
      }
    }
    __builtin_amdgcn_sched_barrier(0);
    {
      const int tk0 = gw * 16;
      float xm1 = bf2f(bxs[(tk0 + 0) * 64 + lane]), x0 = bf2f(bxs[(tk0 + 1) * 64 + lane]), x1 = bf2f(bxs[(tk0 + 2) * 64 + lane]);
#pragma unroll
      for (int e = 0; e < 16; ++e) {
        const int tok = tk0 + e;
        const float x2 = bf2f(bxs[(tok + 3) * 64 + lane]);
        const float xc = cb + xm1 * cw0 + x0 * cw1 + x1 * cw2 + x2 * cw3;
        xcf[tok * 64 + lane] = xc;
        xcb[tok * LDT + lane] = f2bf(xc);
        xm1 = x0; x0 = x1; x1 = x2;
      }
    }
    __syncthreads();
    {
#pragma unroll
      for (int mt = 0; mt < 2; ++mt) {
        const bf16x8 a0 = *(const bf16x8*)(xcb + (mt * 16 + c16) * LDT + g * 8);
        const bf16x8 a1 = *(const bf16x8*)(xcb + (mt * 16 + c16) * LDT + 32 + g * 8);
#pragma unroll
        for (int kk = 0; kk < 2; ++kk) {
          const f32x4 z = {0.f, 0.f, 0.f, 0.f};
          f32x4 ar = mfma16(a1, wf[0][kk][1], mfma16(a0, wf[0][kk][0], z));
          f32x4 ai = mfma16(a1, wf[1][kk][1], mfma16(a0, wf[1][kk][0], z));
          const int ch = (2 * gw + kk) * 16 + c16;
#pragma unroll
          for (int i = 0; i < 4; ++i) {
            const int tok = mt * 16 + g * 4 + i;
            const float r = sigmoidf_(ar[i] + ba[kk]);
            const float ig = sigmoidf_(ai[i] + bx[kk]);
            const float a = __expf(r * sp[kk]);
            const float u = __builtin_amdgcn_sqrtf(fmaxf(1.f - a * a, 0.f)) * (ig * xcf[tok * 64 + ch]);
            af[tok * 64 + ch] = a;
            xcf[tok * 64 + ch] = u;
          }
        }
      }
    }
    __syncthreads();
    if (gw == 0) {
#pragma unroll 1
      for (int bt = 0; bt < 4; ++bt) {
        float av[8], uv[8];
#pragma unroll
        for (int j = 0; j < 8; ++j) {
          const int tok = dir == 0 ? bt * 8 + j : 31 - (bt * 8 + j);
          av[j] = af[tok * 64 + lane];
          uv[j] = xcf[tok * 64 + lane];
        }
#pragma unroll
        for (int j = 0; j < 8; ++j) {
          h = av[j] * h + uv[j];
          if (dep) {
            pp *= av[j];
            const int tok = dir == 0 ? bt * 8 + j : 31 - (bt * 8 + j);
            pbuf[(size_t)(t0 + c * 32 + tok) * 256 + n * 64 + lane] = pp;
          }
          av[j] = h;
        }
#pragma unroll
        for (int j = 0; j < 8; ++j) {
          const int tok = dir == 0 ? bt * 8 + j : 31 - (bt * 8 + j);
          af[tok * 64 + lane] = av[j];
        }
      }
    }
    __syncthreads();
    {
#pragma unroll
      for (int q = 0; q < 4; ++q) {
        const int idx = gt + 128 * q, tok = idx >> 4, c4 = (idx & 15) * 4;
        const size_t t = (size_t)(t0 + c * 32 + tok);
        const float4 hv = *(const float4*)(af + tok * 64 + c4);
        if (!combine) {
          *(float4*)(yown + t * 256 + n * 64 + c4) = hv;
        } else {
          uint2 ov;
          ov.x = pack2((hv.x + py[q].x) * siluf_(lo2f(pg[q].x)), (hv.y + py[q].y) * siluf_(hi2f(pg[q].x)));
          ov.y = pack2((hv.z + py[q].z) * siluf_(lo2f(pg[q].y)), (hv.w + py[q].w) * siluf_(hi2f(pg[q].y)));
          *(uint2*)(br + t * 1024 + 256 + n * 64 + c4) = ov;
        }
      }
      if (ci + 1 < nch) LRU_WRITE()
    }
  }
  if (gw == 0 && !sample) p.out[O_ST + ((size_t)(b * 2 + l) * 2 + dir) * 256 + n * 64 + lane] = h;
  if (split) {
    float* hend = (float*)(p.ws + WS_HEND) + (size_t)((b * 4 + n) * 2) * 64;
    if (gw == 0 && !dep) hend[dir * 64 + lane] = h;
    asm volatile("s_waitcnt vmcnt(0)" ::: "memory");
    __syncthreads();
    volatile int* sj = (volatile int*)(lds + LDS_BYTES - 16);
    if (threadIdx.x == 0) {
      __builtin_amdgcn_fence(__ATOMIC_RELEASE, "agent");
      asm volatile("s_waitcnt vmcnt(0)" ::: "memory");
      const unsigned old = xb_add((unsigned*)(p.ws + WS_BAR) + XB_JOBCTR(64 + l * 32 + b * 4 + n), 1u);
      if (old == 1u) {
        __builtin_amdgcn_fence(__ATOMIC_ACQUIRE, "agent");
        asm volatile("s_waitcnt vmcnt(0)" ::: "memory");
      }
      sj[2] = (int)old;
    }
    __syncthreads();
    if (sj[2] == 1) {
      const float* yf = (const float*)(p.ws + WS_YF);
      const float* yb = (const float*)(p.ws + WS_YB);
#pragma unroll 4
      for (int idx = tid; idx < 1024 * 16; idx += 256) {
        const int tok = idx >> 4, c4 = (idx & 15) * 4;
        const size_t t = (size_t)(t0 + tok);
        float4 f = *(const float4*)(yf + t * 256 + n * 64 + c4);
        float4 bk = *(const float4*)(yb + t * 256 + n * 64 + c4);
        const float4 pq = *(const float4*)(pbuf + t * 256 + n * 64 + c4);
        const uint2 gv = *(const uint2*)(hin + t * INW + 256 + n * 64 + c4);
        if (tok < 512) {
          const float4 hc = *(const float4*)(hend + 64 + c4);
          bk.x += pq.x * hc.x; bk.y += pq.y * hc.y; bk.z += pq.z * hc.z; bk.w += pq.w * hc.w;
        } else {
          const float4 hc = *(const float4*)(hend + c4);
          f.x += pq.x * hc.x; f.y += pq.y * hc.y; f.z += pq.z * hc.z; f.w += pq.w * hc.w;
        }
        uint2 ov;
        ov.x = pack2((f.x + bk.x) * siluf_(lo2f(gv.x)), (f.y + bk.y) * siluf_(hi2f(gv.x)));
        ov.y = pack2((f.z + bk.z) * siluf_(lo2f(gv.y)), (f.w + bk.w) * siluf_(hi2f(gv.y)));
        *(uint2*)(br + t * 1024 + 256 + n * 64 + c4) = ov;
      }
    }
  }
  __syncthreads();
}

__device__ void phase_mix(const Params& p, int l, unsigned char* lds) {
  const int NATT = 192;
  const int per_list = 16 + (l == 0 ? NATT + 122 : NATT);
  unsigned* ctrs = (unsigned*)(p.ws + WS_BAR) + XB_JOBCTR(128 + l * 8);
  volatile int* sjob = (volatile int*)(lds + LDS_BYTES - 16);
  for (bool first = true;; first = false) {
    const int res = next_tile(ctrs, per_list, first, sjob);
    if (res < 0) break;
    const int x = res / per_list, j = res % per_list;
    if (j < 8) { lru_job(p, l, 16 + x, j >> 1, j & 1, lds); continue; }
    if (j < 16) { const int jj = j - 8; lru_job(p, l, 2 * x + (jj >> 2), jj & 3, -1, lds); continue; }
    int a = j - 16;
    if (l == 0) {
      if (a < 244) {
        if (a & 1) {
          const int gid = x * 122 + (a >> 1);
          for (int q = 0; q < 4; ++q) weight_tile(p, 832 + gid * 4 + q, (float*)lds);
          continue;
        }
        a >>= 1;
      } else {
        a = 122 + (a - 244);
      }
    }
    if (a < 64) {
      attn_job<0, true, 1>(p, l, x, a >> 4, a & 15, lds);
    } else if (a < 96) {
      const int r = a - 64;
      attn_job<3, true, 2>(p, l, x, r >> 3, r & 7, lds);
    } else if (a < 128) {
      const int r = a - 96;
      attn_job<2, true, 2>(p, l, x, r >> 3, r & 7, lds);
    } else if (a < 160) {
      const int r = a - 128;
      attn_job<0, false, 1>(p, l, 2 * x + (r >> 4), (r >> 2) & 3, r & 3, lds);
    } else if (a < 176) {
      const int r = a - 160;
      attn_job<2, false, 2>(p, l, 2 * x + (r >> 3), (r >> 1) & 3, r & 1, lds);
    } else {
      const int r = a - 176;
      attn_job<3, false, 2>(p, l, 2 * x + (r >> 3), (r >> 1) & 3, r & 1, lds);
    }
  }
}

__device__ __forceinline__ unsigned long long rfl64(unsigned long long v) {
  const unsigned lo = __builtin_amdgcn_readfirstlane((unsigned)v), hi = __builtin_amdgcn_readfirstlane((unsigned)(v >> 32));
  return ((unsigned long long)hi << 32) | lo;
}
__device__ __forceinline__ Params get_params(const unsigned long long* sp) {
  Params q;
  q.x_prompt = (const float*)(const float __attribute__((address_space(1)))*)rfl64(sp[0]);
  q.x_sample = (const float*)(const float __attribute__((address_space(1)))*)rfl64(sp[1]);
  q.cdk = (const float*)(const float __attribute__((address_space(1)))*)rfl64(sp[2]);
  q.cdv = (const float*)(const float __attribute__((address_space(1)))*)rfl64(sp[3]);
  q.cnk = (const float*)(const float __attribute__((address_space(1)))*)rfl64(sp[4]);
  q.cnv = (const float*)(const float __attribute__((address_space(1)))*)rfl64(sp[5]);
  q.csk = (const float*)(const float __attribute__((address_space(1)))*)rfl64(sp[6]);
  q.csv = (const float*)(const float __attribute__((address_space(1)))*)rfl64(sp[7]);
  q.state = (const float*)(const float __attribute__((address_space(1)))*)rfl64(sp[8]);
  q.c = (const float*)(const float __attribute__((address_space(1)))*)rfl64(sp[9]);
  q.c_ctx = (const float*)(const float __attribute__((address_space(1)))*)rfl64(sp[10]);
  q.norm_g = (const float*)(const float __attribute__((address_space(1)))*)rfl64(sp[11]);
  q.w_ada = (const float*)(const float __attribute__((address_space(1)))*)rfl64(sp[12]);
  q.b_ada = (const float*)(const float __attribute__((address_space(1)))*)rfl64(sp[13]);
  q.w_in = (const float*)(const float __attribute__((address_space(1)))*)rfl64(sp[14]);
  q.dlam = (const float*)(const float __attribute__((address_space(1)))*)rfl64(sp[15]);
  q.dg = (const float*)(const float __attribute__((address_space(1)))*)rfl64(sp[16]);
  q.conv_w = (const float*)(const float __attribute__((address_space(1)))*)rfl64(sp[17]);
  q.conv_b = (const float*)(const float __attribute__((address_space(1)))*)rfl64(sp[18]);
  q.lru_wa = (const float*)(const float __attribute__((address_space(1)))*)rfl64(sp[19]);
  q.lru_ba = (const float*)(const float __attribute__((address_space(1)))*)rfl64(sp[20]);
  q.lru_wx = (const float*)(const float __attribute__((address_space(1)))*)rfl64(sp[21]);
  q.lru_bx = (const float*)(const float __attribute__((address_space(1)))*)rfl64(sp[22]);
  q.lru_lam = (const float*)(const float __attribute__((address_space(1)))*)rfl64(sp[23]);
  q.rpb = (const float*)(const float __attribute__((address_space(1)))*)rfl64(sp[24]);
  q.sink = (const float*)(const float __attribute__((address_space(1)))*)rfl64(sp[25]);
  q.w_mg = (const float*)(const float __attribute__((address_space(1)))*)rfl64(sp[26]);
  q.b_mg = (const float*)(const float __attribute__((address_space(1)))*)rfl64(sp[27]);
  q.w_bo = (const float*)(const float __attribute__((address_space(1)))*)rfl64(sp[28]);
  q.w_o = (const float*)(const float __attribute__((address_space(1)))*)rfl64(sp[29]);
  q.norm_f = (const float*)(const float __attribute__((address_space(1)))*)rfl64(sp[30]);
  q.out = (float*)(float __attribute__((address_space(1)))*)rfl64(sp[31]);
  q.ws = (unsigned char*)(unsigned char __attribute__((address_space(1)))*)rfl64(sp[32]);
  q.ph_lo = 0;
  q.ph_hi = 12;
  return q;
}

__global__ void __launch_bounds__(256, 2) fwd_megakernel(Params p) {
  __shared__ __attribute__((aligned(16))) unsigned char lds[LDS_BYTES];
  __shared__ uint4 xb_words;
  __shared__ unsigned long long sparams[34];
  cg::grid_group grid = cg::this_grid();
  if (threadIdx.x == 0) {
    xb_words = make_uint4(0u, 0u, 0u, 0u);
    sparams[0] = (unsigned long long)p.x_prompt;
    sparams[1] = (unsigned long long)p.x_sample;
    sparams[2] = (unsigned long long)p.cdk;
    sparams[3] = (unsigned long long)p.cdv;
    sparams[4] = (unsigned long long)p.cnk;
    sparams[5] = (unsigned long long)p.cnv;
    sparams[6] = (unsigned long long)p.csk;
    sparams[7] = (unsigned long long)p.csv;
    sparams[8] = (unsigned long long)p.state;
    sparams[9] = (unsigned long long)p.c;
    sparams[10] = (unsigned long long)p.c_ctx;
    sparams[11] = (unsigned long long)p.norm_g;
    sparams[12] = (unsigned long long)p.w_ada;
    sparams[13] = (unsigned long long)p.b_ada;
    sparams[14] = (unsigned long long)p.w_in;
    sparams[15] = (unsigned long long)p.dlam;
    sparams[16] = (unsigned long long)p.dg;
    sparams[17] = (unsigned long long)p.conv_w;
    sparams[18] = (unsigned long long)p.conv_b;
    sparams[19] = (unsigned long long)p.lru_wa;
    sparams[20] = (unsigned long long)p.lru_ba;
    sparams[21] = (unsigned long long)p.lru_wx;
    sparams[22] = (unsigned long long)p.lru_bx;
    sparams[23] = (unsigned long long)p.lru_lam;
    sparams[24] = (unsigned long long)p.rpb;
    sparams[25] = (unsigned long long)p.sink;
    sparams[26] = (unsigned long long)p.w_mg;
    sparams[27] = (unsigned long long)p.b_mg;
    sparams[28] = (unsigned long long)p.w_bo;
    sparams[29] = (unsigned long long)p.w_o;
    sparams[30] = (unsigned long long)p.norm_f;
    sparams[31] = (unsigned long long)p.out;
    sparams[32] = (unsigned long long)p.ws;
  }
  __syncthreads();
  (void)xcd_barrier_post((unsigned*)(p.ws + WS_BAR), (volatile LAS unsigned*)&xb_words);
  if (p.ph_hi < 0) grid.sync();
#define RUN(PH, CALL)                                  \
  {                                                    \
    const Params q = get_params(sparams);              \
    CALL;                                              \
    if ((PH) + 1 < 12) {                               \
      XcdBarrier xb2;                                  \
      xb2.bar = (unsigned*)((unsigned char*)(unsigned char __attribute__((address_space(1)))*)rfl64(sparams[32]) + WS_BAR); \
      xb2.x = xb_xcc_id();                             \
      xb2.st = (volatile LAS unsigned*)&xb_words;      \
      xcd_barrier(xb2);                                \
    }                                                  \
  }
  RUN(0, phase_prep(q, lds))
#pragma unroll 1
  for (int l = 0; l < 2; ++l) {
    RUN(1 + 5 * l, phase_norm(q, l))
    RUN(2 + 5 * l, phase_gemm1(q, l, lds))
    RUN(3 + 5 * l, phase_mix(q, l, lds))
    RUN(4 + 5 * l, phase_merge(q, l, lds))
    RUN(5 + 5 * l, phase_out(q, l, lds))
  }
  RUN(11, phase_final(q))
}

extern "C" void kernel_launch(void* const* d_in, const int* in_sizes, int n_in, void* d_out, int out_size, void* d_ws,
                              size_t ws_size, hipStream_t stream) {
  static int grid_blocks = 0;
  if (!grid_blocks) {
    int dev = 0, cus = 0, per_cu = 0;
    (void)hipGetDevice(&dev);
    (void)hipDeviceGetAttribute(&cus, hipDeviceAttributeMultiprocessorCount, dev);
    (void)hipOccupancyMaxActiveBlocksPerMultiprocessor(&per_cu, fwd_megakernel, 256, 0);
    if (per_cu < 1) per_cu = 1;
    if (per_cu > 2) per_cu = 2;
    grid_blocks = cus * per_cu;
    if (ws_size < WS_TOTAL) fprintf(stderr, "kernel_launch: workspace too small: %zu < %zu\n", ws_size, (size_t)WS_TOTAL);
  }
  Params p{};
  const float** pp = (const float**)&p;
  for (int i = 0; i < 31; ++i) pp[i] = (const float*)d_in[i];
  p.out = (float*)d_out;
  p.ws = (unsigned char*)d_ws;
  p.ph_lo = 0;
  p.ph_hi = 12;
  (void)hipMemsetAsync((unsigned char*)d_ws + WS_BAR, 0, BAR_TOTAL_WORDS * 4, stream);
  void* args[] = {&p};
  hipError_t e = hipLaunchCooperativeKernel((void*)fwd_megakernel, dim3(grid_blocks), dim3(256), args, 0, stream);
  if (e != hipSuccess) fprintf(stderr, "cooperative launch failed: %s (grid %d)\n", hipGetErrorString(e), grid_blocks);
}
```

```cpp
#include <hip/hip_runtime.h>
#include <hip/hip_cooperative_groups.h>
#include <cstdio>
#include <cstdint>
namespace cg = cooperative_groups;

typedef __attribute__((ext_vector_type(8))) short bf16x8;
typedef __attribute__((ext_vector_type(4))) float f32x4;
typedef unsigned short bf16_t;

#define T_TOK 12288
#define T_PR 4096
#define INW 3328

struct Params {
  const float *x_prompt, *x_sample, *cdk, *cdv, *cnk, *cnv, *csk, *csv, *state, *c, *c_ctx, *norm_g, *w_ada, *b_ada,
      *w_in, *dlam, *dg, *conv_w, *conv_b, *lru_wa, *lru_ba, *lru_wx, *lru_bx, *lru_lam, *rpb, *sink, *w_mg, *b_mg,
      *w_bo, *w_o, *norm_f;
  float* out;
  unsigned char* ws;
  int ph_lo, ph_hi;
};

constexpr size_t WS_WIN = 0;
constexpr size_t WS_WMG = WS_WIN + (size_t)2 * 3328 * 1024 * 2;
constexpr size_t WS_WBO = WS_WMG + (size_t)2 * 4096 * 1024 * 2;
constexpr size_t WS_WO = WS_WBO + (size_t)2 * 4 * 1024 * 256 * 2;
constexpr size_t WS_WLRU = WS_WO + (size_t)2 * 1024 * 1024 * 2;
constexpr size_t WS_MOD = WS_WLRU + (size_t)32 * 4096 * 2;
constexpr size_t WS_CVA = WS_MOD + (size_t)2 * 9 * 3072 * 4;
constexpr size_t WS_CVC = WS_CVA + (size_t)64 * 64 * 512 * 2;
constexpr size_t WS_CVD = WS_CVC + (size_t)64 * 64 * 512 * 2;
constexpr size_t WS_TABA = WS_CVD + (size_t)32 * 64 * 512 * 2;
constexpr size_t WS_TABD = WS_TABA + 64 * 8 * 8;
constexpr size_t WS_H = WS_TABD + 64 * 16 * 8;
constexpr size_t WS_HIN = WS_H + (size_t)T_TOK * 1024 * 2;
constexpr size_t WS_AVT = WS_HIN + (size_t)T_TOK * INW * 2;
constexpr size_t WS_CVT = WS_AVT + (size_t)3145728 * 2;
constexpr size_t WS_DVT = WS_CVT + (size_t)3145728 * 2;
constexpr size_t WS_BR = WS_DVT + (size_t)1572864 * 2;
constexpr size_t WS_YF = WS_BR + (size_t)T_TOK * 1024 * 2;
constexpr size_t WS_YB = WS_YF + (size_t)T_TOK * 256 * 4;
constexpr size_t WS_PB = WS_YB + (size_t)T_TOK * 256 * 4;
constexpr size_t WS_HEND = WS_PB + (size_t)T_TOK * 256 * 4;
constexpr size_t WS_END = WS_HEND + 16384;
constexpr size_t WS_MB = WS_HIN;
constexpr size_t WS_BAR = WS_END;
constexpr size_t WS_TOTAL = WS_BAR + 32768;
static_assert(WS_TOTAL <= (size_t)256 * 1024 * 1024, "workspace map exceeds the guaranteed 256 MiB");

constexpr size_t O_Y = 0;
constexpr size_t O_DK = 12582912;
constexpr size_t O_DV = 14680064;
constexpr size_t O_NK = 16777216;
constexpr size_t O_NV = 18874368;
constexpr size_t O_SK = 20971520;
constexpr size_t O_SV = 22020096;
constexpr size_t O_ST = 23068672;

#define LDS_BYTES 53248

__device__ __forceinline__ int tid_opaque() {
  int t = threadIdx.x;
  asm volatile("" : "+v"(t));
  return t;
}
#define TIDX tid_opaque()
__device__ __forceinline__ unsigned pack2(float a, float b) {
  typedef __attribute__((ext_vector_type(2))) __bf16 bf2_t;
  typedef __attribute__((ext_vector_type(2))) float f2_t;
  f2_t v = {a, b};
  bf2_t r = __builtin_convertvector(v, bf2_t);
  return __builtin_bit_cast(unsigned, r);
}
__device__ __forceinline__ bf16_t f2bf(float f) { return (bf16_t)(pack2(f, 0.f) & 0xffffu); }
__device__ __forceinline__ float bf2f(bf16_t h) { return __uint_as_float(((unsigned)h) << 16); }
__device__ __forceinline__ float lo2f(unsigned u) { return __uint_as_float(u << 16); }
__device__ __forceinline__ float hi2f(unsigned u) { return __uint_as_float(u & 0xffff0000u); }
__device__ __forceinline__ float sigmoidf_(float x) { return __builtin_amdgcn_rcpf(1.f + __builtin_amdgcn_exp2f(-1.4426950408889634f * x)); }
__device__ __forceinline__ float siluf_(float x) { return x * __builtin_amdgcn_rcpf(1.f + __builtin_amdgcn_exp2f(-1.4426950408889634f * x)); }
__device__ __forceinline__ float wave_sum(float v) {
#pragma unroll
  for (int o = 32; o >= 1; o >>= 1) v += __shfl_xor(v, o);
  return v;
}
__device__ __forceinline__ float rowmax4(float x) {
  unsigned u = __float_as_uint(x);
  auto r32 = __builtin_amdgcn_permlane32_swap(u, u, false, false);
  const float m = fmaxf(__uint_as_float(r32[0]), __uint_as_float(r32[1]));
  unsigned v = __float_as_uint(m);
  auto r16 = __builtin_amdgcn_permlane16_swap(v, v, false, false);
  return fmaxf(__uint_as_float(r16[0]), __uint_as_float(r16[1]));
}
__device__ __forceinline__ f32x4 mfma16(bf16x8 a, bf16x8 b, f32x4 c) {
  return __builtin_amdgcn_mfma_f32_16x16x32_bf16(a, b, c, 0, 0, 0);
}
__device__ __forceinline__ const float* xrow(const Params& p, int l, int t) {
  if (l == 0) return t < T_PR ? p.x_prompt + (size_t)t * 1024 : p.x_sample + (size_t)(t - T_PR) * 1024;
  return p.out + O_Y + (size_t)t * 1024;
}


#define XB_TMO      128
#define XB_XCNT(j)  (256  + 64 * (j))
#define XB_XSUB(j)  (1280 + 64 * (j))
#define XB_XGEN(j)  (2304 + 64 * (j))
#define XB_TOP      3328
#define XB_TOPGEN   3392
#define XCD_BAR_WORDS 3456
#define XB_JOBCTR(i) (3456 + 16 * (i))
#define BAR_TOTAL_WORDS (3456 + 16 * 160)
#define XB_SPIN_CAP (1u << 22)
#define LAS __attribute__((address_space(3)))
__device__ __forceinline__ unsigned xb_ld(unsigned* p) { return __hip_atomic_load(p, __ATOMIC_RELAXED, __HIP_MEMORY_SCOPE_AGENT); }
__device__ __forceinline__ unsigned xb_add(unsigned* p, unsigned v) { return __hip_atomic_fetch_add(p, v, __ATOMIC_RELAXED, __HIP_MEMORY_SCOPE_AGENT); }
__device__ __forceinline__ unsigned xb_xcc_id() { return (unsigned)__builtin_amdgcn_s_getreg((3 << 11) | 20) & 0xFu; }
#define XB_SPIN(cond, bar) do { unsigned _sp = 0; while (cond) { __builtin_amdgcn_s_sleep(1); \
    if ((++_sp & 255u) == 0u) { if (xb_ld(&(bar)[XB_TMO])) break; if (_sp > XB_SPIN_CAP) { atomicAdd(&(bar)[XB_TMO], 1u); break; } } } } while (0)
struct XcdBarrier { unsigned* bar; unsigned x; volatile LAS unsigned* st; };
__device__ __forceinline__ XcdBarrier xcd_barrier_post(unsigned* bar, volatile LAS unsigned* st) {
  XcdBarrier b; b.bar = bar; b.x = xb_xcc_id(); b.st = st;
  if (threadIdx.x == 0) (void)xb_add(&bar[XB_XCNT(b.x)], 1u);
  return b;
}
__device__ __forceinline__ void xcd_barrier_complete(unsigned* bar, unsigned x, unsigned& nloc, unsigned& nx) {
  const unsigned G = gridDim.x * gridDim.y * gridDim.z;
  unsigned sum, cnt, mine, sp = 0u;
  for (;;) {
    sum = 0u; cnt = 0u; mine = 0u;
#pragma unroll
    for (unsigned j = 0; j < 16; ++j) { const unsigned c = xb_ld(&bar[XB_XCNT(j)]); sum += c; cnt += (c > 0u) ? 1u : 0u; mine = (j == x) ? c : mine; }
    if (sum == G) break;
    __builtin_amdgcn_s_sleep(1);
    if ((++sp & 255u) == 0u) { if (xb_ld(&bar[XB_TMO])) break; if (sp > XB_SPIN_CAP) { atomicAdd(&bar[XB_TMO], 1u); break; } }
  }
  nloc = mine > 0u ? mine : 1u; nx = cnt > 0u ? cnt : 1u;
}
__device__ __forceinline__ void xcd_barrier(const XcdBarrier& b) {
  asm volatile("s_waitcnt vmcnt(0)" ::: "memory");
  __syncthreads();
  if (threadIdx.x == 0) {
    unsigned* bar = b.bar;
    __builtin_amdgcn_s_waitcnt(0);
    unsigned nloc = b.st[0], nx = b.st[1];
    if (nloc == 0u) { xcd_barrier_complete(bar, b.x, nloc, nx); b.st[0] = nloc; b.st[1] = nx; }
    const unsigned old = xb_add(&bar[XB_XSUB(b.x)], 1u);
    const unsigned gen = old / nloc;
    if (old + 1u == (gen + 1u) * nloc) {
      __builtin_amdgcn_fence(__ATOMIC_RELEASE, "agent");
      asm volatile("s_waitcnt vmcnt(0)" ::: "memory");
      const unsigned og = xb_add(&bar[XB_TOP], 1u);
      const unsigned tg = og / nx;
      if (og + 1u == (tg + 1u) * nx) xb_add(&bar[XB_TOPGEN], 1u);
      else XB_SPIN(xb_ld(&bar[XB_TOPGEN]) == tg, bar);
      __builtin_amdgcn_fence(__ATOMIC_ACQUIRE, "agent");
      xb_add(&bar[XB_XGEN(b.x)], 1u);
      asm volatile("s_waitcnt vmcnt(0)" ::: "memory");
    } else {
      XB_SPIN(xb_ld(&bar[XB_XGEN(b.x)]) == gen, bar);
      __builtin_amdgcn_fence(__ATOMIC_ACQUIRE, "agent");
      asm volatile("s_waitcnt vmcnt(0)" ::: "memory");
    }
  }
  __syncthreads();
}

__device__ void transpose_tile(const float* __restrict__ src, int sld, bf16_t* __restrict__ dst, int dld, float* tile) {
  const int tid = TIDX;
  {
    const int r0 = tid >> 4, c4 = (tid & 15) * 4;
#pragma unroll
    for (int i = 0; i < 4; ++i) {
      const int r = r0 + 16 * i;
      const float4 v = *(const float4*)(src + (size_t)r * sld + c4);
      tile[r * 65 + c4 + 0] = v.x;
      tile[r * 65 + c4 + 1] = v.y;
      tile[r * 65 + c4 + 2] = v.z;
      tile[r * 65 + c4 + 3] = v.w;
    }
  }
  __syncthreads();
  {
    const int r8 = (tid & 7) * 8, c0 = tid >> 3;
#pragma unroll
    for (int i = 0; i < 2; ++i) {
      const int c = c0 + 32 * i;
      uint4 o;
      o.x = pack2(tile[(r8 + 0) * 65 + c], tile[(r8 + 1) * 65 + c]);
      o.y = pack2(tile[(r8 + 2) * 65 + c], tile[(r8 + 3) * 65 + c]);
      o.z = pack2(tile[(r8 + 4) * 65 + c], tile[(r8 + 5) * 65 + c]);
      o.w = pack2(tile[(r8 + 6) * 65 + c], tile[(r8 + 7) * 65 + c]);
      *(uint4*)(dst + (size_t)c * dld + r8) = o;
    }
  }
  __syncthreads();
}

__device__ void weight_tile(const Params& p, int job, float* tile) {
  const int NT_LAYER = 832 + 1024 + 256 + 256;
  {
      int l = job / NT_LAYER, j = job % NT_LAYER;
      if (j < 832) {
        int kt = j / 52, nt = j % 52;
        transpose_tile(p.w_in + (size_t)l * 1024 * 3328 + (size_t)kt * 64 * 3328 + nt * 64, 3328,
                       (bf16_t*)(p.ws + WS_WIN) + (size_t)l * 3328 * 1024 + (size_t)nt * 64 * 1024 + kt * 64, 1024, tile);
      } else if (j < 832 + 1024) {
        j -= 832;
        int kt = j / 64, nt = j % 64;
        transpose_tile(p.w_mg + (size_t)l * 1024 * 4096 + (size_t)kt * 64 * 4096 + nt * 64, 4096,
                       (bf16_t*)(p.ws + WS_WMG) + (size_t)l * 4096 * 1024 + (size_t)nt * 64 * 1024 + kt * 64, 1024, tile);
      } else if (j < 832 + 1024 + 256) {
        j -= 832 + 1024;
        int n = j / 64, r = j % 64, wt = r / 16, mt = r % 16;
        transpose_tile(p.w_bo + ((size_t)(l * 4 + n) * 256 + wt * 64) * 1024 + mt * 64, 1024,
                       (bf16_t*)(p.ws + WS_WBO) + ((size_t)(l * 4 + n) * 1024 + mt * 64) * 256 + wt * 64, 256, tile);
      } else {
        j -= 832 + 1024 + 256;
        int kt = j / 16, nt = j % 16;
        transpose_tile(p.w_o + (size_t)l * 1024 * 1024 + (size_t)kt * 64 * 1024 + nt * 64, 1024,
                       (bf16_t*)(p.ws + WS_WO) + (size_t)l * 1024 * 1024 + (size_t)nt * 64 * 1024 + kt * 64, 1024, tile);
      }
  }
}

__device__ void phase_prep(const Params& p, unsigned char* lds) {
  float* tile = (float*)lds;
  const int NT_LAYER = 832 + 1024 + 256 + 256;
  const int NT_W = 2 * NT_LAYER;
  const int NT_LRU = 32;
  const int NT_CV = 512 + 512 + 256;
  const int NT_ALL = NT_W + NT_LRU + NT_CV;
  const int N_MOD = 384;
  const int NJ = NT_ALL + N_MOD + 1;
  bf16_t* wsb = (bf16_t*)p.ws;
  for (int job = blockIdx.x; job < NJ; job += gridDim.x) {
    if (job < NT_W) {
      if (job < 832) weight_tile(p, job, tile);
    } else if (job < NT_W + NT_LRU) {
      int j = job - NT_W;
      int gate = j & 1, rest = j >> 1;
      transpose_tile((gate ? p.lru_wx : p.lru_wa) + (size_t)rest * 4096, 64, (bf16_t*)(p.ws + WS_WLRU) + (size_t)j * 4096, 64, tile);
    } else if (job < NT_ALL) {
      int j = job - NT_W - NT_LRU;
      if (j < 512) {
        int mat = j >> 3, kt = j & 7;
        transpose_tile(p.cdv + (size_t)mat * 512 * 64 + (size_t)kt * 64 * 64, 64, (bf16_t*)(p.ws + WS_CVA) + (size_t)mat * 64 * 512 + kt * 64, 512, tile);
      } else if (j < 1024) {
        j -= 512;
        int mat = j >> 3, kt = j & 7;
        transpose_tile(p.cnv + (size_t)mat * 512 * 64 + (size_t)kt * 64 * 64, 64, (bf16_t*)(p.ws + WS_CVC) + (size_t)mat * 64 * 512 + kt * 64, 512, tile);
      } else {
        j -= 1024;
        int mat = j >> 3, kt = j & 7;
        transpose_tile(p.csv + (size_t)mat * 512 * 64 + (size_t)kt * 64 * 64, 64, (bf16_t*)(p.ws + WS_CVD) + (size_t)mat * 64 * 512 + kt * 64, 512, tile);
      }
    } else if (job < NT_ALL + N_MOD) {
      int j = job - NT_ALL;
      int l = j / 192, j0 = (j % 192) * 16;
      float* sc = (float*)lds;
      const int tid = TIDX;
      for (int e = tid; e < 9 * 1024; e += 256) {
        int v = e >> 10, k = e & 1023;
        float cvv = v == 0 ? p.c_ctx[k] : p.c[(v - 1) * 1024 + k];
        sc[e] = siluf_(cvv);
      }
      __syncthreads();
      const int jj = tid & 15, ks = tid >> 4;
      float acc[9];
#pragma unroll
      for (int v = 0; v < 9; ++v) acc[v] = 0.f;
      const float* wp = p.w_ada + (size_t)l * 1024 * 3072 + j0 + jj;
#pragma unroll 8
      for (int kk = 0; kk < 64; ++kk) {
        int k = ks * 64 + kk;
        float w = wp[(size_t)k * 3072];
#pragma unroll
        for (int v = 0; v < 9; ++v) acc[v] += sc[v * 1024 + k] * w;
      }
      __syncthreads();
      float* red = (float*)lds;
#pragma unroll
      for (int v = 0; v < 9; ++v) red[(ks * 9 + v) * 16 + jj] = acc[v];
      __syncthreads();
      if (tid < 144) {
        int v = tid >> 4, j2 = tid & 15;
        float s = p.b_ada[(size_t)l * 3072 + j0 + j2];
        for (int q = 0; q < 16; ++q) s += red[(q * 9 + v) * 16 + j2];
        ((float*)(p.ws + WS_MOD))[((size_t)l * 9 + v) * 3072 + j0 + j2] = s;
      }
      __syncthreads();
    } else {
      float2* ta = (float2*)(p.ws + WS_TABA);
      float2* td = (float2*)(p.ws + WS_TABD);
      for (int e = TIDX; e < 64 * 8 + 64 * 16; e += 256) {
        if (e < 512) {
          int pos = e >> 3, i = e & 7;
          float inv = powf(10000.f, -(float)i / 8.f);
          float ang = (float)pos * inv;
          ta[e] = make_float2(cosf(ang), sinf(ang));
        } else {
          int e2 = e - 512;
          int pos = e2 >> 4, i = e2 & 15;
          float inv = powf(10000.f, -(float)i / 16.f);
          float ang = (float)pos * inv;
          td[e2] = make_float2(cosf(ang), sinf(ang));
        }
      }
    }
  }
  (void)wsb;
}

__device__ void phase_norm(const Params& p, int l) {
  const int wave = TIDX >> 6, lane = TIDX & 63;
  const float* modl = (const float*)(p.ws + WS_MOD) + (size_t)l * 9 * 3072;
  bf16_t* hb = (bf16_t*)(p.ws + WS_H);
  const float* gp = p.norm_g + l * 1024;
  for (int t = blockIdx.x * 4 + wave; t < T_TOK; t += gridDim.x * 4) {
    const float* xr = xrow(p, l, t);
    const int v = t < T_PR ? 0 : 1 + ((t - T_PR) >> 10);
    const float* shift = modl + v * 3072;
    const float* scale = shift + 1024;
    float4 xv[4];
    float ss = 0.f;
#pragma unroll
    for (int j = 0; j < 4; ++j) {
      xv[j] = *(const float4*)(xr + j * 256 + lane * 4);
      ss += xv[j].x * xv[j].x + xv[j].y * xv[j].y + xv[j].z * xv[j].z + xv[j].w * xv[j].w;
    }
    ss = wave_sum(ss);
    const float rinv = rsqrtf(ss * (1.f / 1024.f) + 1e-6f);
#pragma unroll
    for (int j = 0; j < 4; ++j) {
      const int c = j * 256 + lane * 4;
      float4 gg = *(const float4*)(gp + c), sc = *(const float4*)(scale + c), sh = *(const float4*)(shift + c);
      float h0 = xv[j].x * rinv * gg.x * (1.f + sc.x) + sh.x;
      float h1 = xv[j].y * rinv * gg.y * (1.f + sc.y) + sh.y;
      float h2 = xv[j].z * rinv * gg.z * (1.f + sc.z) + sh.z;
      float h3 = xv[j].w * rinv * gg.w * (1.f + sc.w) + sh.w;
      uint2 o;
      o.x = pack2(h0, h1);
      o.y = pack2(h2, h3);
      *(uint2*)(hb + (size_t)t * 1024 + c) = o;
    }
  }
}

__device__ void phase_final(const Params& p) {
  const int wave = TIDX >> 6, lane = TIDX & 63;
  for (int t = blockIdx.x * 4 + wave; t < T_TOK; t += gridDim.x * 4) {
    float* xr = p.out + O_Y + (size_t)t * 1024;
    float4 xv[4];
    float ss = 0.f;
#pragma unroll
    for (int j = 0; j < 4; ++j) {
      xv[j] = *(const float4*)(xr + j * 256 + lane * 4);
      ss += xv[j].x * xv[j].x + xv[j].y * xv[j].y + xv[j].z * xv[j].z + xv[j].w * xv[j].w;
    }
    ss = wave_sum(ss);
    const float rinv = rsqrtf(ss * (1.f / 1024.f) + 1e-6f);
#pragma unroll
    for (int j = 0; j < 4; ++j) {
      const int c = j * 256 + lane * 4;
      float4 gg = *(const float4*)(p.norm_f + c);
      float4 o;
      o.x = xv[j].x * rinv * gg.x;
      o.y = xv[j].y * rinv * gg.y;
      o.z = xv[j].z * rinv * gg.z;
      o.w = xv[j].w * rinv * gg.w;
      *(float4*)(xr + c) = o;
    }
  }
}

__device__ __forceinline__ int next_tile(unsigned* ctrs, int per_list, bool first, volatile int* sjob) {
  __syncthreads();
  if (threadIdx.x == 0) {
    int res = -1;
    int cur = first ? 0 : sjob[1];
    const unsigned x = xb_xcc_id();
    while (cur < 8) {
      const int lst = (int)((x + (unsigned)cur) & 7u);
      const int v = (int)xb_add(ctrs + lst * 16, 1u);
      if (v < per_list) { res = lst * per_list + v; break; }
      ++cur;
    }
    sjob[1] = cur;
    sjob[0] = res;
  }
  __syncthreads();
  return sjob[0];
}

#define LDT 80
#define LDV 72
template <int NI, bool FDB = true, bool SWAP = false>
__device__ __forceinline__ void gemm_accum(f32x4 (&acc)[4][NI], const bf16_t* __restrict__ A, int lda,
                                           const bf16_t* __restrict__ Bt, int ldb, int K, bf16_t* As, bf16_t* Bs, int bqrows = 32) {
  const int tid = TIDX, lane = tid & 63, wave = tid >> 6, wm = wave >> 1, wn = wave & 1, g = lane >> 4, c16 = lane & 15;
  const int lr = tid >> 3, lc = (tid & 7) * 8;
  const bf16_t* ap = A + (size_t)lr * lda + lc;
  const bf16_t* bp = Bt + (size_t)lr * ldb + lc;
  const size_t a32 = (size_t)32 * lda, b32 = (size_t)bqrows * ldb;
  uint4 ra0 = *(const uint4*)(ap), ra1 = *(const uint4*)(ap + a32), ra2 = *(const uint4*)(ap + 2 * a32), ra3 = *(const uint4*)(ap + 3 * a32);
  uint4 rb0 = *(const uint4*)(bp), rb1 = *(const uint4*)(bp + b32), rb2, rb3;
  if (NI == 4) { rb2 = *(const uint4*)(bp + 2 * b32); rb3 = *(const uint4*)(bp + 3 * b32); }
  for (int k0 = 0; k0 < K; k0 += 64) {
    *(uint4*)(As + (lr + 0) * LDT + lc) = ra0;
    *(uint4*)(As + (lr + 32) * LDT + lc) = ra1;
    *(uint4*)(As + (lr + 64) * LDT + lc) = ra2;
    *(uint4*)(As + (lr + 96) * LDT + lc) = ra3;
    *(uint4*)(Bs + (lr + 0) * LDT + lc) = rb0;
    *(uint4*)(Bs + (lr + 32) * LDT + lc) = rb1;
    if (NI == 4) {
      *(uint4*)(Bs + (lr + 64) * LDT + lc) = rb2;
      *(uint4*)(Bs + (lr + 96) * LDT + lc) = rb3;
    }
    __syncthreads();
    {
      const int kn = (k0 + 64 < K) ? k0 + 64 : k0;
      ra0 = *(const uint4*)(ap + kn);
      ra1 = *(const uint4*)(ap + a32 + kn);
      ra2 = *(const uint4*)(ap + 2 * a32 + kn);
      ra3 = *(const uint4*)(ap + 3 * a32 + kn);
      rb0 = *(const uint4*)(bp + kn);
      rb1 = *(const uint4*)(bp + b32 + kn);
      if (NI == 4) {
        rb2 = *(const uint4*)(bp + 2 * b32 + kn);
        rb3 = *(const uint4*)(bp + 3 * b32 + kn);
      }
    }
    __builtin_amdgcn_sched_barrier(0);
    if (FDB) {
      bf16x8 af0[4], bf0[NI], af1[4], bf1[NI];
      const bf16_t* arow = As + (wm * 64 + c16) * LDT + g * 8;
      const bf16_t* brow = Bs + (wn * 16 * NI + c16) * LDT + g * 8;
#pragma unroll
      for (int i = 0; i < 4; ++i) af0[i] = *(const bf16x8*)(arow + i * 16 * LDT);
#pragma unroll
      for (int j = 0; j < NI; ++j) bf0[j] = *(const bf16x8*)(brow + j * 16 * LDT);
#pragma unroll
      for (int i = 0; i < 4; ++i) af1[i] = *(const bf16x8*)(arow + i * 16 * LDT + 32);
#pragma unroll
      for (int j = 0; j < NI; ++j) bf1[j] = *(const bf16x8*)(brow + j * 16 * LDT + 32);
      __builtin_amdgcn_sched_barrier(0);
#pragma unroll
      for (int i = 0; i < 4; ++i)
#pragma unroll
        for (int j = 0; j < NI; ++j) acc[i][j] = SWAP ? mfma16(bf0[j], af0[i], acc[i][j]) : mfma16(af0[i], bf0[j], acc[i][j]);
#pragma unroll
      for (int i = 0; i < 4; ++i)
#pragma unroll
        for (int j = 0; j < NI; ++j) acc[i][j] = SWAP ? mfma16(bf1[j], af1[i], acc[i][j]) : mfma16(af1[i], bf1[j], acc[i][j]);
    } else {
#pragma unroll
      for (int ks = 0; ks < 2; ++ks) {
        bf16x8 af[4], bfr[NI];
#pragma unroll
        for (int i = 0; i < 4; ++i) af[i] = *(const bf16x8*)(As + (wm * 64 + i * 16 + c16) * LDT + ks * 32 + g * 8);
#pragma unroll
        for (int j = 0; j < NI; ++j) bfr[j] = *(const bf16x8*)(Bs + (wn * 16 * NI + j * 16 + c16) * LDT + ks * 32 + g * 8);
#pragma unroll
        for (int i = 0; i < 4; ++i)
#pragma unroll
          for (int j = 0; j < NI; ++j) acc[i][j] = SWAP ? mfma16(bfr[j], af[i], acc[i][j]) : mfma16(af[i], bfr[j], acc[i][j]);
      }
    }
    __syncthreads();
  }
}

__device__ void phase_gemm1(const Params& p, int l, unsigned char* lds) {
  bf16_t* As = (bf16_t*)lds;
  bf16_t* Bs = As + 128 * LDT;
  const bf16_t* hb = (const bf16_t*)(p.ws + WS_H);
  const bf16_t* wt = (const bf16_t*)(p.ws + WS_WIN) + (size_t)l * 3328 * 1024;
  bf16_t* hin = (bf16_t*)(p.ws + WS_HIN);
  const float2* tabA = (const float2*)(p.ws + WS_TABA);
  const float2* tabD = (const float2*)(p.ws + WS_TABD);
  const int lane = TIDX & 63, wave = TIDX >> 6, wm = wave >> 1, wn = wave & 1, g = lane >> 4, c16 = lane & 15;
  unsigned* ctrs = (unsigned*)(p.ws + WS_BAR) + XB_JOBCTR(8 + l * 24);
  volatile int* sjob = (volatile int*)(lds + LDS_BYTES - 16);
  for (int tile = blockIdx.x; tile < 96 * 26; tile += gridDim.x) {
    const int rt = tile / 26, ct = tile % 26;
    const int row0 = rt * 128, col0 = ct * 128;
    f32x4 acc[4][4];
#pragma unroll
    for (int i = 0; i < 4; ++i)
#pragma unroll
      for (int j = 0; j < 4; ++j) acc[i][j] = (f32x4){0.f, 0.f, 0.f, 0.f};
    const bool vtile = (col0 >= 1536 && col0 < 1792) || (col0 >= 2560 && col0 < 2816) || col0 >= 3200;
    const int cw = col0 + wn * 64;
    const int rw = row0 + wm * 64;
    const bool sample = row0 >= T_PR;
    int b, pbase, L;
    if (!sample) { b = rw >> 8; pbase = rw & 255; L = 256; }
    else { b = (rw - T_PR) >> 10; pbase = (rw - T_PR) & 1023; L = 1024; }
    if (vtile) {
      gemm_accum<4, true, false>(acc, hb + (size_t)row0 * 1024, 1024, wt + (size_t)col0 * 1024, 1024, 1024, As, Bs);
      int vkind, vhead, vnh = 4;
      if (cw < 1792) { vkind = 0; vhead = (cw - 1536) >> 6; }
      else if (cw < 2816) { vkind = 1; vhead = (cw - 2560) >> 6; }
      else { vkind = 2; vhead = (cw - 3200) >> 6; vnh = 2; }
      bf16_t* vt = (bf16_t*)(p.ws + (vkind == 0 ? WS_AVT : vkind == 1 ? WS_CVT : WS_DVT));
      const size_t base = sample ? (size_t)16 * vnh * 64 * 256 + (size_t)(b * vnh + vhead) * 64 * 1024 : (size_t)(b * vnh + vhead) * 64 * 256;
#pragma unroll
      for (int mi = 0; mi < 4; ++mi)
#pragma unroll
        for (int ni = 0; ni < 4; ++ni) {
          const int d = ni * 16 + c16;
          uint2 o;
          o.x = pack2(acc[mi][ni][0], acc[mi][ni][1]);
          o.y = pack2(acc[mi][ni][2], acc[mi][ni][3]);
          *(uint2*)(vt + base + (size_t)d * L + pbase + mi * 16 + g * 4) = o;
        }
      if (!sample) {
        float* ob = p.out + (vkind == 0 ? O_DV : vkind == 1 ? O_NV : O_SV) + (size_t)((b * 2 + l) * vnh + vhead) * 256 * 64;
#pragma unroll
        for (int mi = 0; mi < 4; ++mi)
#pragma unroll
          for (int i = 0; i < 4; ++i) {
            const int pos = pbase + mi * 16 + g * 4 + i;
#pragma unroll
            for (int ni = 0; ni < 4; ++ni) ob[(size_t)pos * 64 + ni * 16 + c16] = acc[mi][ni][i];
          }
      }
    } else {
      gemm_accum<4, true, true>(acc, hb + (size_t)row0 * 1024, 1024, wt + (size_t)col0 * 1024, 1024, 1024, As, Bs);
      const bool ropeA = sample && cw >= 1024 && cw < 1536;
      const bool ropeD = sample && cw >= 2816 && cw < 3200;
      if (ropeA) {
#pragma unroll
        for (int i = 0; i < 4; ++i) {
          const int pos = pbase + i * 16 + c16;
          const int prow = pos >> 6, pcol = pos & 63;
#pragma unroll
          for (int j = 0; j < 4; ++j)
#pragma unroll
            for (int r = 0; r < 4; ++r) {
              const float2 cs = tabA[((j & 1) ? pcol : prow) * 8 + (g & 1) * 4 + r];
              const float own = acc[i][j][r];
              const float oth = __shfl_xor(own, 32);
              acc[i][j][r] = (g < 2) ? (own * cs.x - oth * cs.y) : (oth * cs.y + own * cs.x);
            }
        }
      } else if (ropeD) {
#pragma unroll
        for (int i = 0; i < 4; ++i) {
          const int pos = pbase + i * 16 + c16;
          const int prow = pos >> 6, pcol = pos & 63;
#pragma unroll
          for (int r = 0; r < 4; ++r) {
            {
              const float2 cs = tabD[prow * 16 + g * 4 + r];
              const float x1 = acc[i][0][r], x2 = acc[i][1][r];
              acc[i][0][r] = x1 * cs.x - x2 * cs.y;
              acc[i][1][r] = x1 * cs.y + x2 * cs.x;
            }
            {
              const float2 cs = tabD[pcol * 16 + g * 4 + r];
              const float x1 = acc[i][2][r], x2 = acc[i][3][r];
              acc[i][2][r] = x1 * cs.x - x2 * cs.y;
              acc[i][3][r] = x1 * cs.y + x2 * cs.x;
            }
          }
        }
      }
#pragma unroll
      for (int i = 0; i < 4; ++i) {
        const size_t r = (size_t)(rw + i * 16 + c16);
#pragma unroll
        for (int j = 0; j < 4; j += 2) {
          const unsigned ax = pack2(acc[i][j][0], acc[i][j][1]), ay = pack2(acc[i][j][2], acc[i][j][3]);
          const unsigned bx = pack2(acc[i][j + 1][0], acc[i][j + 1][1]), by = pack2(acc[i][j + 1][2], acc[i][j + 1][3]);
          auto sx = __builtin_amdgcn_permlane16_swap(ax, bx, false, false);
          auto sy = __builtin_amdgcn_permlane16_swap(ay, by, false, false);
          uint4 o;
          o.x = sx[0]; o.y = sy[0]; o.z = sx[1]; o.w = sy[1];
          const int col = cw + (j + (g & 1)) * 16 + (g & 2) * 4;
          *(uint4*)(hin + r * INW + col) = o;
        }
      }
      if (!sample) {
        float* ob = nullptr;
        int kind = -1;
        if (cw >= 1280 && cw < 1536) { kind = 0; ob = p.out + O_DK + ((size_t)((b * 2 + l) * 4 + ((cw - 1280) >> 6)) * 2) * 256 * 32; }
        else if (cw >= 2304 && cw < 2560) { kind = 1; ob = p.out + O_NK + (size_t)((b * 2 + l) * 4 + ((cw - 2304) >> 6)) * 256 * 64; }
        else if (cw >= 3072 && cw < 3200) { kind = 1; ob = p.out + O_SK + (size_t)((b * 2 + l) * 2 + ((cw - 3072) >> 6)) * 256 * 64; }
        if (kind == 0) {
#pragma unroll
          for (int i = 0; i < 4; ++i) {
            const int pos = pbase + i * 16 + c16;
#pragma unroll
            for (int j = 0; j < 4; ++j) {
              const float4 o = {acc[i][j][0], acc[i][j][1], acc[i][j][2], acc[i][j][3]};
              *(float4*)(ob + ((size_t)(j >> 1) * 256 + pos) * 32 + (j & 1) * 16 + g * 4) = o;
            }
          }
        } else if (kind == 1) {
#pragma unroll
          for (int i = 0; i < 4; ++i) {
            const int pos = pbase + i * 16 + c16;
#pragma unroll
            for (int j = 0; j < 4; ++j) {
              const float4 o = {acc[i][j][0], acc[i][j][1], acc[i][j][2], acc[i][j][3]};
              *(float4*)(ob + (size_t)pos * 64 + j * 16 + g * 4) = o;
            }
          }
        }
      }
    }
  }
}

__device__ void phase_merge(const Params& p, int l, unsigned char* lds) {
  bf16_t* As = (bf16_t*)lds;
  bf16_t* Bs = As + 128 * LDT;
  const bf16_t* hb = (const bf16_t*)(p.ws + WS_H);
  const bf16_t* br = (const bf16_t*)(p.ws + WS_BR);
  const bf16_t* wmg = (const bf16_t*)(p.ws + WS_WMG) + (size_t)l * 4096 * 1024;
  const bf16_t* wbo = (const bf16_t*)(p.ws + WS_WBO) + (size_t)l * 4 * 1024 * 256;
  bf16_t* mb = (bf16_t*)(p.ws + WS_MB);
  unsigned* ctrs = (unsigned*)(p.ws + WS_BAR) + XB_JOBCTR(16 + l * 24);
  volatile int* sjob = (volatile int*)(lds + LDS_BYTES - 16);
  for (int tile = blockIdx.x; tile < 96 * 8; tile += gridDim.x) {
    const int rt = tile >> 3, ct = tile & 7;
    const int row0 = rt * 128, col0 = ct * 128;
    f32x4 macc[4][4];
#pragma unroll
    for (int i = 0; i < 4; ++i)
#pragma unroll
      for (int j = 0; j < 4; ++j) macc[i][j] = (f32x4){0.f, 0.f, 0.f, 0.f};
#pragma unroll 1
    for (int n = 0; n < 4; ++n) {
      uint2 gp[4][4];
      {
        f32x4 G[4][4];
#pragma unroll
        for (int i = 0; i < 4; ++i)
#pragma unroll
          for (int j = 0; j < 4; ++j) G[i][j] = (f32x4){0.f, 0.f, 0.f, 0.f};
        gemm_accum<4, false, true>(G, hb + (size_t)row0 * 1024, 1024, wmg + (size_t)(n * 1024 + col0) * 1024, 1024, 1024, As, Bs);
        const int lane1 = TIDX & 63, wn1 = (TIDX >> 6) & 1, g1 = lane1 >> 4;
#pragma unroll
        for (int j = 0; j < 4; ++j) {
          const float4 bb = *(const float4*)(p.b_mg + (size_t)l * 4096 + n * 1024 + col0 + wn1 * 64 + j * 16 + g1 * 4);
#pragma unroll
          for (int i = 0; i < 4; ++i) {
            gp[i][j].x = pack2(sigmoidf_(G[i][j][0] + bb.x), sigmoidf_(G[i][j][1] + bb.y));
            gp[i][j].y = pack2(sigmoidf_(G[i][j][2] + bb.z), sigmoidf_(G[i][j][3] + bb.w));
          }
        }
      }
#pragma unroll
      for (int hh = 0; hh < 2; ++hh) {
        f32x4 Pa[4][2];
#pragma unroll
        for (int i = 0; i < 4; ++i)
#pragma unroll
          for (int j = 0; j < 2; ++j) Pa[i][j] = (f32x4){0.f, 0.f, 0.f, 0.f};
        gemm_accum<2, true, true>(Pa, br + (size_t)row0 * 1024 + n * 256, 1024, wbo + (size_t)(n * 1024 + col0 + hh * 32) * 256, 256, 256, As, Bs, 64);
#pragma unroll
        for (int i = 0; i < 4; ++i)
#pragma unroll
          for (int j = 0; j < 2; ++j) {
            macc[i][hh * 2 + j][0] += lo2f(gp[i][hh * 2 + j].x) * Pa[i][j][0];
            macc[i][hh * 2 + j][1] += hi2f(gp[i][hh * 2 + j].x) * Pa[i][j][1];
            macc[i][hh * 2 + j][2] += lo2f(gp[i][hh * 2 + j].y) * Pa[i][j][2];
            macc[i][hh * 2 + j][3] += hi2f(gp[i][hh * 2 + j].y) * Pa[i][j][3];
          }
      }
    }
    const int lane = TIDX & 63, wave = TIDX >> 6, wm = wave >> 1, wn = wave & 1, g = lane >> 4, c16 = lane & 15;
#pragma unroll
    for (int i = 0; i < 4; ++i) {
      const size_t r = (size_t)(row0 + wm * 64 + i * 16 + c16);
#pragma unroll
      for (int j = 0; j < 4; j += 2) {
        const unsigned ax = pack2(macc[i][j][0], macc[i][j][1]), ay = pack2(macc[i][j][2], macc[i][j][3]);
        const unsigned bx = pack2(macc[i][j + 1][0], macc[i][j + 1][1]), by = pack2(macc[i][j + 1][2], macc[i][j + 1][3]);
        auto sx = __builtin_amdgcn_permlane16_swap(ax, bx, false, false);
        auto sy = __builtin_amdgcn_permlane16_swap(ay, by, false, false);
        uint4 o;
        o.x = sx[0]; o.y = sy[0]; o.z = sx[1]; o.w = sy[1];
        *(uint4*)(mb + r * 1024 + col0 + wn * 64 + (j + (g & 1)) * 16 + (g & 2) * 4) = o;
      }
    }
  }
}

__device__ void phase_out(const Params& p, int l, unsigned char* lds) {
  bf16_t* As = (bf16_t*)lds;
  bf16_t* Bs = As + 128 * LDT;
  const bf16_t* mb = (const bf16_t*)(p.ws + WS_MB);
  const bf16_t* wo = (const bf16_t*)(p.ws + WS_WO) + (size_t)l * 1024 * 1024;
  const float* modl = (const float*)(p.ws + WS_MOD) + (size_t)l * 9 * 3072;
  const int lane = TIDX & 63, wave = TIDX >> 6, wm = wave >> 1, wn = wave & 1, g = lane >> 4, c16 = lane & 15;
  unsigned* ctrs = (unsigned*)(p.ws + WS_BAR) + XB_JOBCTR(24 + l * 24);
  volatile int* sjob = (volatile int*)(lds + LDS_BYTES - 16);
  for (int tile = blockIdx.x; tile < 96 * 8; tile += gridDim.x) {
    const int rt = tile >> 3, ct = tile & 7;
    const int row0 = rt * 128, col0 = ct * 128;
    f32x4 acc[4][4];
#pragma unroll
    for (int i = 0; i < 4; ++i)
#pragma unroll
      for (int j = 0; j < 4; ++j) acc[i][j] = (f32x4){0.f, 0.f, 0.f, 0.f};
    gemm_accum<4, true, true>(acc, mb + (size_t)row0 * 1024, 1024, wo + (size_t)col0 * 1024, 1024, 1024, As, Bs);
    const int v = row0 < T_PR ? 0 : 1 + ((row0 - T_PR) >> 10);
    const float* gate = modl + v * 3072 + 2048;
#pragma unroll
    for (int j = 0; j < 4; ++j) {
      const int col = col0 + wn * 64 + j * 16 + g * 4;
      const float4 gt = *(const float4*)(gate + col);
#pragma unroll
      for (int i = 0; i < 4; ++i) {
        const int t = row0 + wm * 64 + i * 16 + c16;
        const float4 xo = *(const float4*)(xrow(p, l, t) + col);
        float4 o;
        o.x = xo.x + gt.x * acc[i][j][0];
        o.y = xo.y + gt.y * acc[i][j][1];
        o.z = xo.z + gt.z * acc[i][j][2];
        o.w = xo.w + gt.w * acc[i][j][3];
        *(float4*)(p.out + O_Y + (size_t)t * 1024 + col) = o;
      }
    }
  }
}

template <int NM, int MODE>
__device__ __forceinline__ void attn_chunk(const bf16_t* Ks, const bf16_t* Vts, int koff, const bf16x8 (&qf)[2], float scale,
                                           float (&m_run)[NM], float (&l_run)[NM], f32x4 (&o)[NM][4], int lane,
                                           int qa, int qb, int ka, const float* rpbh) {
  const int g = lane >> 4, r16 = lane & 15;
  f32x4 s[NM][2];
#pragma unroll
  for (int kt = 0; kt < 2; ++kt) {
    const bf16_t* kp = Ks + (koff + kt * 16 + r16) * LDT + g * 8;
    const bf16x8 k0 = *(const bf16x8*)kp;
    const bf16x8 k1 = *(const bf16x8*)(kp + 32);
    const f32x4 z = {0.f, 0.f, 0.f, 0.f};
    if (NM == 2) {
      s[0][kt] = mfma16(k0, qf[0], z);
      s[NM - 1][kt] = mfma16(k1, qf[1], z);
    } else {
      s[0][kt] = mfma16(k1, qf[1], mfma16(k0, qf[0], z));
    }
  }
  bool valid[2][4];
  float bias[2][4];
#pragma unroll
  for (int kt = 0; kt < 2; ++kt)
#pragma unroll
    for (int i = 0; i < 4; ++i) {
      valid[kt][i] = true;
      bias[kt][i] = 0.f;
      const int kk = koff + kt * 16 + g * 4 + i;
      if (MODE == 1) {
        int cs = qb - 8;
        cs = cs < 0 ? 0 : (cs > 48 ? 48 : cs);
        const bool ok = (kk >= cs) && (kk < cs + 16);
        valid[kt][i] = ok;
        int dc = kk - qb + 15;
        dc = dc < 0 ? 0 : (dc > 30 ? 30 : dc);
        bias[kt][i] = rpbh[(ka - qa + 7) * 31 + dc] * 1.4426950408889634f;
      } else if (MODE == 2) {
        const int kp = ka + kt * 16 + g * 4 + i;
        int df = qa - kp;
        df = df < 0 ? -df : df;
        valid[kt][i] = df <= 128;
      }
    }
  bf16x8 pb[NM];
#pragma unroll
  for (int m = 0; m < NM; ++m) {
    float x[2][4];
    float mx = -1e30f;
#pragma unroll
    for (int kt = 0; kt < 2; ++kt)
#pragma unroll
      for (int i = 0; i < 4; ++i) {
        float xv = MODE == 1 ? fmaf(s[m][kt][i], scale, bias[kt][i]) : s[m][kt][i] * scale;
        if (MODE != 0) xv = valid[kt][i] ? xv : -1e30f;
        x[kt][i] = xv;
        mx = fmaxf(mx, xv);
      }
    mx = rowmax4(mx);
    const float mn = fmaxf(m_run[m], mx);
    const float alpha = __builtin_amdgcn_exp2f(m_run[m] - mn);
    m_run[m] = mn;
    float ps = 0.f;
    float pv[8];
#pragma unroll
    for (int kt = 0; kt < 2; ++kt)
#pragma unroll
      for (int i = 0; i < 4; ++i) {
        float e = __builtin_amdgcn_exp2f(x[kt][i] - mn);
        if (MODE != 0) e = valid[kt][i] ? e : 0.f;
        pv[kt * 4 + i] = e;
        ps += e;
      }
    l_run[m] = l_run[m] * alpha + ps;
#pragma unroll
    for (int dt = 0; dt < 4; ++dt) {
      o[m][dt][0] *= alpha;
      o[m][dt][1] *= alpha;
      o[m][dt][2] *= alpha;
      o[m][dt][3] *= alpha;
    }
    union { bf16x8 v; unsigned u[4]; } pk;
    pk.u[0] = pack2(pv[0], pv[1]);
    pk.u[1] = pack2(pv[2], pv[3]);
    pk.u[2] = pack2(pv[4], pv[5]);
    pk.u[3] = pack2(pv[6], pv[7]);
    pb[m] = pk.v;
  }
#pragma unroll
  for (int dt = 0; dt < 4; ++dt) {
    const bf16_t* vp = Vts + (dt * 16 + r16) * LDV + koff + g * 4;
    union { bf16x8 v; uint2 u[2]; } vf;
    vf.u[0] = *(const uint2*)vp;
    vf.u[1] = *(const uint2*)(vp + 16);
#pragma unroll
    for (int m = 0; m < NM; ++m) o[m][dt] = mfma16(vf.v, pb[m], o[m][dt]);
  }
}

template <int NM, int MODE>
__device__ __forceinline__ void attn_tile64(const bf16_t* Ks, const bf16_t* Vts, const bf16x8 (&qf)[2],
                                            float (&m_run)[NM], float (&l_run)[NM], f32x4 (&o)[NM][4], int lane, int qa, int ka,
                                            bool first) {
  const int g = lane >> 4, r16 = lane & 15;
  f32x4 s[NM][4];
  f32x4 ci[NM];
#pragma unroll
  for (int m = 0; m < NM; ++m) {
    const float c = first ? 0.f : -m_run[m];
    ci[m] = (f32x4){c, c, c, c};
  }
#pragma unroll
  for (int kt = 0; kt < 4; ++kt) {
    const bf16_t* kp = Ks + (kt * 16 + r16) * LDT + g * 8;
    const bf16x8 k0 = *(const bf16x8*)kp;
    const bf16x8 k1 = *(const bf16x8*)(kp + 32);
    if (NM == 2) {
      s[0][kt] = mfma16(k0, qf[0], ci[0]);
      s[NM - 1][kt] = mfma16(k1, qf[1], ci[NM - 1]);
    } else {
      s[0][kt] = mfma16(k1, qf[1], mfma16(k0, qf[0], ci[0]));
    }
  }
  if (MODE == 2) {
#pragma unroll
    for (int kt = 0; kt < 4; ++kt)
#pragma unroll
      for (int i = 0; i < 4; ++i) {
        int df = qa - (ka + kt * 16 + g * 4 + i);
        df = df < 0 ? -df : df;
        const bool ok = df <= 128;
#pragma unroll
        for (int m = 0; m < NM; ++m) s[m][kt][i] = ok ? s[m][kt][i] : -1e30f;
      }
  }
  bf16x8 pbA[NM], pbB[NM];
#pragma unroll
  for (int m = 0; m < NM; ++m) {
    float mx = fmaxf(fmaxf(fmaxf(s[m][0][0], s[m][0][1]), fmaxf(s[m][0][2], s[m][0][3])),
                     fmaxf(fmaxf(s[m][1][0], s[m][1][1]), fmaxf(s[m][1][2], s[m][1][3])));
    mx = fmaxf(mx, fmaxf(fmaxf(fmaxf(s[m][2][0], s[m][2][1]), fmaxf(s[m][2][2], s[m][2][3])),
                         fmaxf(fmaxf(s[m][3][0], s[m][3][1]), fmaxf(s[m][3][2], s[m][3][3]))));
    mx = rowmax4(mx);
    if (first || __any(mx > 0.f)) {
      const float d = first ? mx : fmaxf(mx, 0.f);
      const float alpha = first ? 0.f : __builtin_amdgcn_exp2f(-d);
      m_run[m] = first ? d : m_run[m] + d;
      l_run[m] *= alpha;
#pragma unroll
      for (int dt = 0; dt < 4; ++dt) o[m][dt] *= alpha;
#pragma unroll
      for (int kt = 0; kt < 4; ++kt) s[m][kt] -= d;
    }
    f32x4 ps4 = {0.f, 0.f, 0.f, 0.f};
#pragma unroll
    for (int kt = 0; kt < 4; ++kt) {
      s[m][kt][0] = __builtin_amdgcn_exp2f(s[m][kt][0]);
      s[m][kt][1] = __builtin_amdgcn_exp2f(s[m][kt][1]);
      s[m][kt][2] = __builtin_amdgcn_exp2f(s[m][kt][2]);
      s[m][kt][3] = __builtin_amdgcn_exp2f(s[m][kt][3]);
      ps4 += s[m][kt];
    }
    l_run[m] += (ps4[0] + ps4[1]) + (ps4[2] + ps4[3]);
    union { bf16x8 v; unsigned u[4]; } pk;
    pk.u[0] = pack2(s[m][0][0], s[m][0][1]);
    pk.u[1] = pack2(s[m][0][2], s[m][0][3]);
    pk.u[2] = pack2(s[m][1][0], s[m][1][1]);
    pk.u[3] = pack2(s[m][1][2], s[m][1][3]);
    pbA[m] = pk.v;
    pk.u[0] = pack2(s[m][2][0], s[m][2][1]);
    pk.u[1] = pack2(s[m][2][2], s[m][2][3]);
    pk.u[2] = pack2(s[m][3][0], s[m][3][1]);
    pk.u[3] = pack2(s[m][3][2], s[m][3][3]);
    pbB[m] = pk.v;
  }
#pragma unroll
  for (int dt = 0; dt < 4; ++dt) {
    const bf16_t* vp = Vts + (dt * 16 + r16) * LDV + g * 4;
    union { bf16x8 v; uint2 u[2]; } vfA, vfB;
    vfA.u[0] = *(const uint2*)vp;
    vfA.u[1] = *(const uint2*)(vp + 16);
    vfB.u[0] = *(const uint2*)(vp + 32);
    vfB.u[1] = *(const uint2*)(vp + 48);
#pragma unroll
    for (int m = 0; m < NM; ++m) {
      o[m][dt] = mfma16(vfA.v, pbA[m], o[m][dt]);
      o[m][dt] = mfma16(vfB.v, pbB[m], o[m][dt]);
    }
  }
}

template <int BR, bool SAMPLE, int QG>
__device__ void attn_job(const Params& p, int l, int b, int head, int qp, unsigned char* lds) {
  constexpr int L = SAMPLE ? 1024 : 256;
  constexpr int NM = BR == 0 ? 2 : 1;
  constexpr int QCOL = BR == 0 ? 1024 : (BR == 2 ? 2048 : 2816);
  constexpr int KCOL = BR == 0 ? 1280 : (BR == 2 ? 2304 : 3072);
  constexpr int GCOL = BR == 0 ? 0 : (BR == 2 ? 512 : 768);
  constexpr int NKH = BR == 3 ? 2 : 4;
  bf16_t* Ks = (bf16_t*)lds;
  bf16_t* Vts = Ks + 64 * LDT;
  const int tid = TIDX, lane = tid & 63, w = tid >> 6, g = lane >> 4, qi = lane & 15;
  const int t0 = SAMPLE ? T_PR + b * 1024 : b * 256;
  int qpos[QG], tq[QG];
#pragma unroll
  for (int gq = 0; gq < QG; ++gq) {
    qpos[gq] = (QG * qp + gq) * 64 + w * 16 + qi;
    tq[gq] = t0 + qpos[gq];
  }
  const bf16_t* hin = (const bf16_t*)(p.ws + WS_HIN);
  const int kvh = BR == 3 ? (head >> 1) : head;
  const int kcol = KCOL + kvh * 64;
  const bf16_t* vT = (const bf16_t*)(p.ws + (BR == 0 ? WS_AVT : (BR == 2 ? WS_CVT : WS_DVT))) +
                     (SAMPLE ? (size_t)16 * NKH * 64 * 256 + (size_t)(b * NKH + kvh) * 64 * 1024 : (size_t)(b * NKH + kvh) * 64 * 256);
  const int cmat = (b * 2 + l) * NKH + kvh;
  const bf16_t* cvt = (const bf16_t*)(p.ws + (BR == 0 ? WS_CVA : (BR == 2 ? WS_CVC : WS_CVD))) + (size_t)cmat * 64 * 512;
  bf16x8 qf[QG][2];
  float m_run[QG][NM], l_run[QG][NM];
  f32x4 o[QG][NM][4];
#pragma unroll
  for (int gq = 0; gq < QG; ++gq) {
    qf[gq][0] = *(const bf16x8*)(hin + (size_t)tq[gq] * INW + QCOL + head * 64 + g * 8);
    qf[gq][1] = *(const bf16x8*)(hin + (size_t)tq[gq] * INW + QCOL + head * 64 + 32 + g * 8);
    const float qs = (BR == 0 ? 0.17677669529663687f : 0.125f) * 1.4426950408889634f;
#pragma unroll
    for (int i = 0; i < 2; ++i) {
      union { bf16x8 v; unsigned u[4]; } t;
      t.v = qf[gq][i];
#pragma unroll
      for (int w2 = 0; w2 < 4; ++w2) t.u[w2] = pack2(lo2f(t.u[w2]) * qs, hi2f(t.u[w2]) * qs);
      qf[gq][i] = t.v;
    }
#pragma unroll
    for (int m = 0; m < NM; ++m) {
      m_run[gq][m] = -1e30f;
      l_run[gq][m] = 0.f;
#pragma unroll
      for (int dt = 0; dt < 4; ++dt) o[gq][m][dt] = (f32x4){0.f, 0.f, 0.f, 0.f};
    }
    if (BR == 3) {
      m_run[gq][0] = p.sink[l * 4 + head] * 1.4426950408889634f;
      l_run[gq][0] = (g == 0) ? 1.f : 0.f;
    }
  }
  const float scale = 1.f;
  const int nctx = SAMPLE ? 8 : 0;
  int loc0 = 0, nloc = 4;
  int glo[QG], ghi[QG];
#pragma unroll
  for (int gq = 0; gq < QG; ++gq) { glo[gq] = 0; ghi[gq] = 3; }
  if (SAMPLE) {
#pragma unroll
    for (int gq = 0; gq < QG; ++gq) {
      const int qtg = QG * qp + gq;
      if (BR == 0) { glo[gq] = 0; ghi[gq] = 15; }
      else if (BR == 2) { int rs = qtg - 4; rs = rs < 0 ? 0 : (rs > 8 ? 8 : rs); glo[gq] = rs; ghi[gq] = rs + 7; }
      else { glo[gq] = qtg - 2 < 0 ? 0 : qtg - 2; ghi[gq] = qtg + 2 > 15 ? 15 : qtg + 2; }
    }
    loc0 = glo[0];
    nloc = ghi[QG - 1] - glo[0] + 1;
  }
  const float* rpbh = p.rpb + (size_t)(l * 4 + head) * 15 * 31;
  const int nb = w * 16 - 8;
  const int boff = nb < 0 ? 0 : (nb > 32 ? 32 : nb);
  const int ntl = nctx + nloc;
  const int skey = tid >> 2, sseg = tid & 3;
  float4 kr0 = make_float4(0.f, 0.f, 0.f, 0.f), kr1 = kr0, kr2 = kr0, kr3 = kr0;
  uint4 vr0, vr1;
#define ATT_ISSUE(IT2)                                                                                                   \
  {                                                                                                                      \
    const int it2_ = (IT2);                                                                                              \
    const bool c2 = it2_ < nctx;                                                                                         \
    const int kt2 = c2 ? it2_ : loc0 + (it2_ - nctx);                                                                    \
    if (c2) {                                                                                                            \
      const float* src;                                                                                                  \
      if (BR == 0) src = p.cdk + ((((size_t)(b * 2 + l) * 4 + head) * 2 + (sseg >> 1)) * 512 + kt2 * 64 + skey) * 32 + (sseg & 1) * 16; \
      else if (BR == 2) src = p.cnk + (((size_t)(b * 2 + l) * 4 + head) * 512 + kt2 * 64 + skey) * 64 + sseg * 16;      \
      else src = p.csk + (((size_t)(b * 2 + l) * 2 + kvh) * 512 + kt2 * 64 + skey) * 64 + sseg * 16;                     \
      kr0 = ((const float4*)src)[0];                                                                                     \
      kr1 = ((const float4*)src)[1];                                                                                     \
      kr2 = ((const float4*)src)[2];                                                                                     \
      kr3 = ((const float4*)src)[3];                                                                                     \
    } else {                                                                                                             \
      const bf16_t* src = hin + (size_t)(t0 + kt2 * 64 + skey) * INW + kcol + sseg * 16;                                 \
      kr0 = ((const float4*)src)[0];                                                                                     \
      kr1 = ((const float4*)src)[1];                                                                                     \
    }                                                                                                                    \
    const bf16_t* vsrc = c2 ? cvt + (size_t)skey * 512 + kt2 * 64 + sseg * 16 : vT + (size_t)skey * L + kt2 * 64 + sseg * 16; \
    vr0 = ((const uint4*)vsrc)[0];                                                                                       \
    vr1 = ((const uint4*)vsrc)[1];                                                                                       \
  }
#define ATT_WRITE(CTX, KB, VB)                                                                                        \
  {                                                                                                                      \
    uint4 u0, u1;                                                                                                        \
    if (CTX) {                                                                                                           \
      u0.x = pack2(kr0.x, kr0.y); u0.y = pack2(kr0.z, kr0.w); u0.z = pack2(kr1.x, kr1.y); u0.w = pack2(kr1.z, kr1.w);    \
      u1.x = pack2(kr2.x, kr2.y); u1.y = pack2(kr2.z, kr2.w); u1.z = pack2(kr3.x, kr3.y); u1.w = pack2(kr3.z, kr3.w);    \
    } else {                                                                                                             \
      u0 = __builtin_bit_cast(uint4, kr0);                                                                               \
      u1 = __builtin_bit_cast(uint4, kr1);                                                                               \
    }                                                                                                                    \
    *(uint4*)((KB) + skey * LDT + sseg * 16) = u0;                                                                       \
    *(uint4*)((KB) + skey * LDT + sseg * 16 + 8) = u1;                                                                   \
    *(uint4*)((VB) + skey * LDV + sseg * 16) = vr0;                                                                      \
    *(uint4*)((VB) + skey * LDV + sseg * 16 + 8) = vr1;                                                                  \
  }
  constexpr int KVB = 64 * LDT + 64 * LDV;
  __syncthreads();
  ATT_ISSUE(0)
  ATT_WRITE(0 < nctx, Ks, Vts)
  if (1 < ntl) ATT_ISSUE(1)
  __syncthreads();
  for (int it = 0; it < ntl; ++it) {
    const bool isctx = it < nctx;
    const int kt = isctx ? it : loc0 + (it - nctx);
    const bf16_t* Kc = Ks + (it & 1) * KVB;
    const bf16_t* Vc = Vts + (it & 1) * KVB;
    if (it + 1 < ntl) ATT_WRITE(it + 1 < nctx, Ks + ((it + 1) & 1) * KVB, Vts + ((it + 1) & 1) * KVB)
    if (it + 2 < ntl) ATT_ISSUE(it + 2)
    __builtin_amdgcn_sched_barrier(0);
#pragma unroll
    for (int gq = 0; gq < QG; ++gq) {
      if (!isctx && (kt < glo[gq] || kt > ghi[gq])) continue;
      if (SAMPLE && BR == 2 && !isctx) {
        attn_chunk<NM, 1>(Kc, Vc, boff, qf[gq], scale, m_run[gq], l_run[gq], o[gq], lane, QG * qp + gq, w * 16 + qi, kt, rpbh);
      } else if (SAMPLE && BR == 3 && !isctx) {
        attn_tile64<NM, 2>(Kc, Vc, qf[gq], m_run[gq], l_run[gq], o[gq], lane, qpos[gq], kt * 64, false);
      } else {
        attn_tile64<NM, 0>(Kc, Vc, qf[gq], m_run[gq], l_run[gq], o[gq], lane, 0, 0, BR != 3 && it == 0);
      }
    }
    __syncthreads();
  }
#undef ATT_WRITE
  float lam = 0.f, lam_init = 0.f;
  if (BR == 0) {
    float s01 = 0.f, s23 = 0.f;
    for (int e = 0; e < 32; ++e) {
      s01 += p.dlam[l * 128 + e] * p.dlam[l * 128 + 32 + e];
      s23 += p.dlam[l * 128 + 64 + e] * p.dlam[l * 128 + 96 + e];
    }
    lam_init = 0.8f - 0.6f * expf(-0.3f * (float)l);
    lam = expf(s01) - expf(s23) + lam_init;
  }
  bf16_t* br = (bf16_t*)(p.ws + WS_BR);
#pragma unroll
  for (int gq = 0; gq < QG; ++gq) {
    float linv[NM];
#pragma unroll
    for (int m = 0; m < NM; ++m) {
      float lt = l_run[gq][m];
      lt += __shfl_xor(lt, 16);
      lt += __shfl_xor(lt, 32);
      linv[m] = 1.f / lt;
    }
    float y[4][4];
    if (BR == 0) {
      float ss = 0.f;
#pragma unroll
      for (int dt = 0; dt < 4; ++dt)
#pragma unroll
        for (int i = 0; i < 4; ++i) {
          float v = o[gq][0][dt][i] * linv[0] - lam * (o[gq][NM - 1][dt][i] * linv[NM - 1]);
          y[dt][i] = v;
          ss += v * v;
        }
      ss += __shfl_xor(ss, 16);
      ss += __shfl_xor(ss, 32);
      const float rinv = rsqrtf(ss * (1.f / 64.f) + 1e-6f) * (1.f - lam_init);
#pragma unroll
      for (int dt = 0; dt < 4; ++dt)
#pragma unroll
        for (int i = 0; i < 4; ++i) y[dt][i] *= rinv * p.dg[l * 64 + dt * 16 + g * 4 + i];
    } else {
#pragma unroll
      for (int dt = 0; dt < 4; ++dt)
#pragma unroll
        for (int i = 0; i < 4; ++i) y[dt][i] = o[gq][0][dt][i] * linv[0];
    }
    uint2 ovv[4];
#pragma unroll
    for (int dt = 0; dt < 4; ++dt) {
      const int d = dt * 16 + g * 4;
      const uint2 gv = *(const uint2*)(hin + (size_t)tq[gq] * INW + GCOL + head * 64 + d);
      ovv[dt].x = pack2(y[dt][0] * siluf_(lo2f(gv.x)), y[dt][1] * siluf_(hi2f(gv.x)));
      ovv[dt].y = pack2(y[dt][2] * siluf_(lo2f(gv.y)), y[dt][3] * siluf_(hi2f(gv.y)));
    }
#pragma unroll
    for (int dt = 0; dt < 4; dt += 2) {
      auto sx = __builtin_amdgcn_permlane16_swap(ovv[dt].x, ovv[dt + 1].x, false, false);
      auto sy = __builtin_amdgcn_permlane16_swap(ovv[dt].y, ovv[dt + 1].y, false, false);
      uint4 o;
      o.x = sx[0]; o.y = sy[0]; o.z = sx[1]; o.w = sy[1];
      *(uint4*)(br + (size_t)tq[gq] * 1024 + GCOL + head * 64 + (dt + (g & 1)) * 16 + (g & 2) * 4) = o;
    }
  }
}

__device__ void lru_job(const Params& p, int l, int seq, int n, int half, unsigned char* lds) {
  const bool sample = seq >= 16;
  const int b = sample ? seq - 16 : seq;
  const int L = sample ? 1024 : 256;
  const int t0 = sample ? T_PR + b * 1024 : b * 256;
  const int tid = TIDX, dir = tid >> 7, gt = tid & 127, gw = (tid >> 6) & 1, lane = tid & 63, g = lane >> 4, c16 = lane & 15;
  unsigned char* base = lds + dir * 26112;
  bf16_t* bxs = (bf16_t*)base;
  bf16_t* xcb = (bf16_t*)(base + 4480);
  float* xcf = (float*)(base + 4480 + 5120);
  float* af = (float*)(base + 4480 + 5120 + 8192);
  const bf16_t* hin = (const bf16_t*)(p.ws + WS_HIN);
  const bf16_t* wl = (const bf16_t*)(p.ws + WS_WLRU) + (size_t)(((l * 2 + dir) * 4 + n) * 2) * 4096;
  bf16x8 wf[2][2][2];
#pragma unroll
  for (int gate = 0; gate < 2; ++gate)
#pragma unroll
    for (int kk = 0; kk < 2; ++kk)
#pragma unroll
      for (int ks = 0; ks < 2; ++ks)
        wf[gate][kk][ks] = *(const bf16x8*)(wl + (size_t)gate * 4096 + ((2 * gw + kk) * 16 + c16) * 64 + ks * 32 + g * 8);
  float ba[2], bx[2], sp[2];
#pragma unroll
  for (int kk = 0; kk < 2; ++kk) {
    const int ch = n * 64 + (2 * gw + kk) * 16 + c16;
    ba[kk] = p.lru_ba[(l * 2 + dir) * 256 + ch];
    bx[kk] = p.lru_bx[(l * 2 + dir) * 256 + ch];
    const float lm = p.lru_lam[(l * 2 + dir) * 256 + ch];
    sp[kk] = -8.f * log1pf(expf(-lm));
  }
  const int cch = n * 64 + lane;
  const float cw0 = p.conv_w[(l * 4 + 0) * 256 + cch], cw1 = p.conv_w[(l * 4 + 1) * 256 + cch], cw2 = p.conv_w[(l * 4 + 2) * 256 + cch],
              cw3 = p.conv_w[(l * 4 + 3) * 256 + cch], cb = p.conv_b[l * 256 + cch];
  const bool split = half >= 0;
  const bool dep = split && (dir == 0 ? half == 1 : half == 0);
  float h = 0.f, pp = 1.f;
  if (sample && !dep) h = p.state[((size_t)(b * 2 + l) * 2 + dir) * 256 + n * 64 + lane];
  float* pbuf = (float*)(p.ws + WS_PB);
  float* yown = (float*)(p.ws + (dir == 0 ? WS_YF : WS_YB));
  const float* yoth = (const float*)(p.ws + (dir == 0 ? WS_YB : WS_YF));
  bf16_t* br = (bf16_t*)(p.ws + WS_BR);
  const int nch = split ? 16 : L / 32;
  const int c_lo = split ? half * 16 : 0;
  uint4 rw0, rw1, rw2;
#define LRU_ISSUE(CC)                                                                                               \
  {                                                                                                                    \
    const int cc_ = (CC);                                                                                              \
    {                                                                                                                  \
      const int idx = gt, r = idx >> 3, sg = idx & 7, pos = cc_ * 32 - 1 + r;                                          \
      const bool ok = pos >= 0 && pos < L;                                                                             \
      const int pc = ok ? pos : 0;                                                                                     \
      uint4 v = *(const uint4*)(hin + (size_t)(t0 + pc) * INW + 1792 + n * 64 + sg * 8);                               \
      rw0.x = ok ? v.x : 0u; rw0.y = ok ? v.y : 0u; rw0.z = ok ? v.z : 0u; rw0.w = ok ? v.w : 0u;                      \
    }                                                                                                                  \
    {                                                                                                                  \
      const int idx = gt + 128, r = idx >> 3, sg = idx & 7, pos = cc_ * 32 - 1 + r;                                    \
      const bool ok = pos >= 0 && pos < L;                                                                             \
      const int pc = ok ? pos : 0;                                                                                     \
      uint4 v = *(const uint4*)(hin + (size_t)(t0 + pc) * INW + 1792 + n * 64 + sg * 8);                               \
      rw1.x = ok ? v.x : 0u; rw1.y = ok ? v.y : 0u; rw1.z = ok ? v.z : 0u; rw1.w = ok ? v.w : 0u;                      \
    }                                                                                                                  \
    {                                                                                                                  \
      const int idx = gt + 256, r = idx >> 3, sg = idx & 7, pos = cc_ * 32 - 1 + r;                                    \
      const bool ok = idx < 280 && pos >= 0 && pos < L;                                                                \
      const int pc = ok ? pos : 0;                                                                                     \
      uint4 v = *(const uint4*)(hin + (size_t)(t0 + pc) * INW + 1792 + n * 64 + sg * 8);                               \
      rw2.x = ok ? v.x : 0u; rw2.y = ok ? v.y : 0u; rw2.z = ok ? v.z : 0u; rw2.w = ok ? v.w : 0u;                      \
    }                                                                                                                  \
  }
#define LRU_WRITE()                                                                         \
  {                                                                                         \
    *(uint4*)(bxs + (gt >> 3) * 64 + (gt & 7) * 8) = rw0;                                   \
    *(uint4*)(bxs + ((gt + 128) >> 3) * 64 + (gt & 7) * 8) = rw1;                           \
    if (gt + 256 < 280) *(uint4*)(bxs + ((gt + 256) >> 3) * 64 + (gt & 7) * 8) = rw2;       \
  }
  LRU_ISSUE(c_lo + (dir == 0 ? 0 : nch - 1))
  LRU_WRITE()
  for (int ci = 0; ci < nch; ++ci) {
    const int c = c_lo + (dir == 0 ? ci : nch - 1 - ci);
    const bool combine = !split && ci >= (nch >> 1);
    __syncthreads();
    if (ci + 1 < nch) LRU_ISSUE(dir == 0 ? c + 1 : c - 1)
    float4 py[4];
    uint2 pg[4];
    if (combine) {
#pragma unroll
      for (int q = 0; q < 4; ++q) {
        const int idx = gt + 128 * q, tok = idx >> 4, c4 = (idx & 15) * 4;
        const size_t t = (size_t)(t0 + c * 32 + tok);
        py[q] = *(const float4*)(yoth + t * 256 + n * 64 + c4);
        pg[q] = *(const uint2*)(hin + t * INW + 256 + n * 64 + c4);
      }
    }
    __builtin_amdgcn_sched_barrier(0);
    {
      const int tk0 = gw * 16;
      float xm1 = bf2f(bxs[(tk0 + 0) * 64 + lane]), x0 = bf2f(bxs[(tk0 + 1) * 64 + lane]), x1 = bf2f(bxs[(tk0 + 2) * 64 + lane]);
#pragma unroll
      for (int e = 0; e < 16; ++e) {
        const int tok = tk0 + e;
        const float x2 = bf2f(bxs[(tok + 3) * 64 + lane]);
        const float xc = cb + xm1 * cw0 + x0 * cw1 + x1 * cw2 + x2 * cw3;
        xcf[tok * 64 + lane] = xc;
        xcb[tok * LDT + lane] = f2bf(xc);
        xm1 = x0; x0 = x1; x1 = x2;
      }
    }
    __syncthreads();
    {
#pragma unroll
      for (int mt = 0; mt < 2; ++mt) {
        const bf16x8 a0 = *(const bf16x8*)(xcb + (mt * 16 + c16) * LDT + g * 8);
        const bf16x8 a1 = *(const bf16x8*)(xcb + (mt * 16 + c16) * LDT + 32 + g * 8);
#pragma unroll
        for (int kk = 0; kk < 2; ++kk) {
          const f32x4 z = {0.f, 0.f, 0.f, 0.f};
          f32x4 ar = mfma16(a1, wf[0][kk][1], mfma16(a0, wf[0][kk][0], z));
          f32x4 ai = mfma16(a1, wf[1][kk][1], mfma16(a0, wf[1][kk][0], z));
          const int ch = (2 * gw + kk) * 16 + c16;
#pragma unroll
          for (int i = 0; i < 4; ++i) {
            const int tok = mt * 16 + g * 4 + i;
            const float r = sigmoidf_(ar[i] + ba[kk]);
            const float ig = sigmoidf_(ai[i] + bx[kk]);
            const float a = __expf(r * sp[kk]);
            const float u = __builtin_amdgcn_sqrtf(fmaxf(1.f - a * a, 0.f)) * (ig * xcf[tok * 64 + ch]);
            af[tok * 64 + ch] = a;
            xcf[tok * 64 + ch] = u;
          }
        }
      }
    }
    __syncthreads();
    if (gw == 0) {
#pragma unroll 1
      for (int bt = 0; bt < 4; ++bt) {
        float av[8], uv[8];
#pragma unroll
        for (int j = 0; j < 8; ++j) {
          const int tok = dir == 0 ? bt * 8 + j : 31 - (bt * 8 + j);
          av[j] = af[tok * 64 + lane];
          uv[j] = xcf[tok * 64 + lane];
        }
#pragma unroll
        for (int j = 0; j < 8; ++j) {
          h = av[j] * h + uv[j];
          if (dep) {
            pp *= av[j];
            const int tok = dir == 0 ? bt * 8 + j : 31 - (bt * 8 + j);
            pbuf[(size_t)(t0 + c * 32 + tok) * 256 + n * 64 + lane] = pp;
          }
          av[j] = h;
        }
#pragma unroll
        for (int j = 0; j < 8; ++j) {
          const int tok = dir == 0 ? bt * 8 + j : 31 - (bt * 8 + j);
          af[tok * 64 + lane] = av[j];
        }
      }
    }
    __syncthreads();
    {
#pragma unroll
      for (int q = 0; q < 4; ++q) {
        const int idx = gt + 128 * q, tok = idx >> 4, c4 = (idx & 15) * 4;
        const size_t t = (size_t)(t0 + c * 32 + tok);
        const float4 hv = *(const float4*)(af + tok * 64 + c4);
        if (!combine) {
          *(float4*)(yown + t * 256 + n * 64 + c4) = hv;
        } else {
          uint2 ov;
          ov.x = pack2((hv.x + py[q].x) * siluf_(lo2f(pg[q].x)), (hv.y + py[q].y) * siluf_(hi2f(pg[q].x)));
          ov.y = pack2((hv.z + py[q].z) * siluf_(lo2f(pg[q].y)), (hv.w + py[q].w) * siluf_(hi2f(pg[q].y)));
          *(uint2*)(br + t * 1024 + 256 + n * 64 + c4) = ov;
        }
      }
      if (ci + 1 < nch) LRU_WRITE()
    }
  }
  if (gw == 0 && !sample) p.out[O_ST + ((size_t)(b * 2 + l) * 2 + dir) * 256 + n * 64 + lane] = h;
  if (split) {
    float* hend = (float*)(p.ws + WS_HEND) + (size_t)((b * 4 + n) * 2) * 64;
    if (gw == 0 && !dep) hend[dir * 64 + lane] = h;
    asm volatile("s_waitcnt vmcnt(0)" ::: "memory");
    __syncthreads();
    volatile int* sj = (volatile int*)(lds + LDS_BYTES - 16);
    if (threadIdx.x == 0) {
      __builtin_amdgcn_fence(__ATOMIC_RELEASE, "agent");
      asm volatile("s_waitcnt vmcnt(0)" ::: "memory");
      const unsigned old = xb_add((unsigned*)(p.ws + WS_BAR) + XB_JOBCTR(64 + l * 32 + b * 4 + n), 1u);
      if (old == 1u) {
        __builtin_amdgcn_fence(__ATOMIC_ACQUIRE, "agent");
        asm volatile("s_waitcnt vmcnt(0)" ::: "memory");
      }
      sj[2] = (int)old;
    }
    __syncthreads();
    if (sj[2] == 1) {
      const float* yf = (const float*)(p.ws + WS_YF);
      const float* yb = (const float*)(p.ws + WS_YB);
#pragma unroll 4
      for (int idx = tid; idx < 1024 * 16; idx += 256) {
        const int tok = idx >> 4, c4 = (idx & 15) * 4;
        const size_t t = (size_t)(t0 + tok);
        float4 f = *(const float4*)(yf + t * 256 + n * 64 + c4);
        float4 bk = *(const float4*)(yb + t * 256 + n * 64 + c4);
        const float4 pq = *(const float4*)(pbuf + t * 256 + n * 64 + c4);
        const uint2 gv = *(const uint2*)(hin + t * INW + 256 + n * 64 + c4);
        if (tok < 512) {
          const float4 hc = *(const float4*)(hend + 64 + c4);
          bk.x += pq.x * hc.x; bk.y += pq.y * hc.y; bk.z += pq.z * hc.z; bk.w += pq.w * hc.w;
        } else {
          const float4 hc = *(const float4*)(hend + c4);
          f.x += pq.x * hc.x; f.y += pq.y * hc.y; f.z += pq.z * hc.z; f.w += pq.w * hc.w;
        }
        uint2 ov;
        ov.x = pack2((f.x + bk.x) * siluf_(lo2f(gv.x)), (f.y + bk.y) * siluf_(hi2f(gv.x)));
        ov.y = pack2((f.z + bk.z) * siluf_(lo2f(gv.y)), (f.w + bk.w) * siluf_(hi2f(gv.y)));
        *(uint2*)(br + t * 1024 + 256 + n * 64 + c4) = ov;
      }
    }
  }
  __syncthreads();
}

__device__ void phase_mix(const Params& p, int l, unsigned char* lds) {
  const int NATT = 192;
  const int per_list = 16 + (l == 0 ? NATT + 122 : NATT);
  unsigned* ctrs = (unsigned*)(p.ws + WS_BAR) + XB_JOBCTR(128 + l * 8);
  volatile int* sjob = (volatile int*)(lds + LDS_BYTES - 16);
  for (bool first = true;; first = false) {
    const int res = next_tile(ctrs, per_list, first, sjob);
    if (res < 0) break;
    const int x = res / per_list, j = res % per_list;
    if (j < 8) { lru_job(p, l, 16 + x, j >> 1, j & 1, lds); continue; }
    if (j < 16) { const int jj = j - 8; lru_job(p, l, 2 * x + (jj >> 2), jj & 3, -1, lds); continue; }
    int a = j - 16;
    if (l == 0) {
      if (a < 244) {
        if (a & 1) {
          const int gid = x * 122 + (a >> 1);
          for (int q = 0; q < 4; ++q) weight_tile(p, 832 + gid * 4 + q, (float*)lds);
          continue;
        }
        a >>= 1;
      } else {
        a = 122 + (a - 244);
      }
    }
    if (a < 64) {
      attn_job<0, true, 1>(p, l, x, a >> 4, a & 15, lds);
    } else if (a < 96) {
      const int r = a - 64;
      attn_job<3, true, 2>(p, l, x, r >> 3, r & 7, lds);
    } else if (a < 128) {
      const int r = a - 96;
      attn_job<2, true, 2>(p, l, x, r >> 3, r & 7, lds);
    } else if (a < 160) {
      const int r = a - 128;
      attn_job<0, false, 1>(p, l, 2 * x + (r >> 4), (r >> 2) & 3, r & 3, lds);
    } else if (a < 176) {
      const int r = a - 160;
      attn_job<2, false, 2>(p, l, 2 * x + (r >> 3), (r >> 1) & 3, r & 1, lds);
    } else {
      const int r = a - 176;
      attn_job<3, false, 2>(p, l, 2 * x + (r >> 3), (r >> 1) & 3, r & 1, lds);
    }
  }
}

__device__ __forceinline__ unsigned long long rfl64(unsigned long long v) {
  const unsigned lo = __builtin_amdgcn_readfirstlane((unsigned)v), hi = __builtin_amdgcn_readfirstlane((unsigned)(v >> 32));
  return ((unsigned long long)hi << 32) | lo;
}
__device__ __forceinline__ Params get_params(const unsigned long long* sp) {
  Params q;
  q.x_prompt = (const float*)(const float __attribute__((address_space(1)))*)rfl64(sp[0]);
  q.x_sample = (const float*)(const float __attribute__((address_space(1)))*)rfl64(sp[1]);
  q.cdk = (const float*)(const float __attribute__((address_space(1)))*)rfl64(sp[2]);
  q.cdv = (const float*)(const float __attribute__((address_space(1)))*)rfl64(sp[3]);
  q.cnk = (const float*)(const float __attribute__((address_space(1)))*)rfl64(sp[4]);
  q.cnv = (const float*)(const float __attribute__((address_space(1)))*)rfl64(sp[5]);
  q.csk = (const float*)(const float __attribute__((address_space(1)))*)rfl64(sp[6]);
  q.csv = (const float*)(const float __attribute__((address_space(1)))*)rfl64(sp[7]);
  q.state = (const float*)(const float __attribute__((address_space(1)))*)rfl64(sp[8]);
  q.c = (const float*)(const float __attribute__((address_space(1)))*)rfl64(sp[9]);
  q.c_ctx = (const float*)(const float __attribute__((address_space(1)))*)rfl64(sp[10]);
  q.norm_g = (const float*)(const float __attribute__((address_space(1)))*)rfl64(sp[11]);
  q.w_ada = (const float*)(const float __attribute__((address_space(1)))*)rfl64(sp[12]);
  q.b_ada = (const float*)(const float __attribute__((address_space(1)))*)rfl64(sp[13]);
  q.w_in = (const float*)(const float __attribute__((address_space(1)))*)rfl64(sp[14]);
  q.dlam = (const float*)(const float __attribute__((address_space(1)))*)rfl64(sp[15]);
  q.dg = (const float*)(const float __attribute__((address_space(1)))*)rfl64(sp[16]);
  q.conv_w = (const float*)(const float __attribute__((address_space(1)))*)rfl64(sp[17]);
  q.conv_b = (const float*)(const float __attribute__((address_space(1)))*)rfl64(sp[18]);
  q.lru_wa = (const float*)(const float __attribute__((address_space(1)))*)rfl64(sp[19]);
  q.lru_ba = (const float*)(const float __attribute__((address_space(1)))*)rfl64(sp[20]);
  q.lru_wx = (const float*)(const float __attribute__((address_space(1)))*)rfl64(sp[21]);
  q.lru_bx = (const float*)(const float __attribute__((address_space(1)))*)rfl64(sp[22]);
  q.lru_lam = (const float*)(const float __attribute__((address_space(1)))*)rfl64(sp[23]);
  q.rpb = (const float*)(const float __attribute__((address_space(1)))*)rfl64(sp[24]);
  q.sink = (const float*)(const float __attribute__((address_space(1)))*)rfl64(sp[25]);
  q.w_mg = (const float*)(const float __attribute__((address_space(1)))*)rfl64(sp[26]);
  q.b_mg = (const float*)(const float __attribute__((address_space(1)))*)rfl64(sp[27]);
  q.w_bo = (const float*)(const float __attribute__((address_space(1)))*)rfl64(sp[28]);
  q.w_o = (const float*)(const float __attribute__((address_space(1)))*)rfl64(sp[29]);
  q.norm_f = (const float*)(const float __attribute__((address_space(1)))*)rfl64(sp[30]);
  q.out = (float*)(float __attribute__((address_space(1)))*)rfl64(sp[31]);
  q.ws = (unsigned char*)(unsigned char __attribute__((address_space(1)))*)rfl64(sp[32]);
  q.ph_lo = 0;
  q.ph_hi = 12;
  return q;
}

__global__ void __launch_bounds__(256, 2) fwd_megakernel(Params p) {
  __shared__ __attribute__((aligned(16))) unsigned char lds[LDS_BYTES];
  __shared__ uint4 xb_words;
  __shared__ unsigned long long sparams[34];
  cg::grid_group grid = cg::this_grid();
  if (threadIdx.x == 0) {
    xb_words = make_uint4(0u, 0u, 0u, 0u);
    sparams[0] = (unsigned long long)p.x_prompt;
    sparams[1] = (unsigned long long)p.x_sample;
    sparams[2] = (unsigned long long)p.cdk;
    sparams[3] = (unsigned long long)p.cdv;
    sparams[4] = (unsigned long long)p.cnk;
    sparams[5] = (unsigned long long)p.cnv;
    sparams[6] = (unsigned long long)p.csk;
    sparams[7] = (unsigned long long)p.csv;
    sparams[8] = (unsigned long long)p.state;
    sparams[9] = (unsigned long long)p.c;
    sparams[10] = (unsigned long long)p.c_ctx;
    sparams[11] = (unsigned long long)p.norm_g;
    sparams[12] = (unsigned long long)p.w_ada;
    sparams[13] = (unsigned long long)p.b_ada;
    sparams[14] = (unsigned long long)p.w_in;
    sparams[15] = (unsigned long long)p.dlam;
    sparams[16] = (unsigned long long)p.dg;
    sparams[17] = (unsigned long long)p.conv_w;
    sparams[18] = (unsigned long long)p.conv_b;
    sparams[19] = (unsigned long long)p.lru_wa;
    sparams[20] = (unsigned long long)p.lru_ba;
    sparams[21] = (unsigned long long)p.lru_wx;
    sparams[22] = (unsigned long long)p.lru_bx;
    sparams[23] = (unsigned long long)p.lru_lam;
    sparams[24] = (unsigned long long)p.rpb;
    sparams[25] = (unsigned long long)p.sink;
    sparams[26] = (unsigned long long)p.w_mg;
    sparams[27] = (unsigned long long)p.b_mg;
    sparams[28] = (unsigned long long)p.w_bo;
    sparams[29] = (unsigned long long)p.w_o;
    sparams[30] = (unsigned long long)p.norm_f;
    sparams[31] = (unsigned long long)p.out;
    sparams[32] = (unsigned long long)p.ws;
  }
  __syncthreads();
  (void)xcd_barrier_post((unsigned*)(p.ws + WS_BAR), (volatile LAS unsigned*)&xb_words);
  if (p.ph_hi < 0) grid.sync();
#define RUN(PH, CALL)                                  \
  {                                                    \
    const Params q = get_params(sparams);              \
    CALL;                                              \
    if ((PH) + 1 < 12) {                               \
      XcdBarrier xb2;                                  \
      xb2.bar = (unsigned*)((unsigned char*)(unsigned char __attribute__((address_space(1)))*)rfl64(sparams[32]) + WS_BAR); \
      xb2.x = xb_xcc_id();                             \
      xb2.st = (volatile LAS unsigned*)&xb_words;      \
      xcd_barrier(xb2);                                \
    }                                                  \
  }
  RUN(0, phase_prep(q, lds))
#pragma unroll 1
  for (int l = 0; l < 2; ++l) {
    RUN(1 + 5 * l, phase_norm(q, l))
    RUN(2 + 5 * l, phase_gemm1(q, l, lds))
    RUN(3 + 5 * l, phase_mix(q, l, lds))
    RUN(4 + 5 * l, phase_merge(q, l, lds))
    RUN(5 + 5 * l, phase_out(q, l, lds))
  }
  RUN(11, phase_final(q))
}

extern "C" void kernel_launch(void* const* d_in, const int* in_sizes, int n_in, void* d_out, int out_size, void* d_ws,
                              size_t ws_size, hipStream_t stream) {
  static int grid_blocks = 0;
  if (!grid_blocks) {
    int dev = 0, cus = 0, per_cu = 0;
    (void)hipGetDevice(&dev);
    (void)hipDeviceGetAttribute(&cus, hipDeviceAttributeMultiprocessorCount, dev);
    (void)hipOccupancyMaxActiveBlocksPerMultiprocessor(&per_cu, fwd_megakernel, 256, 0);
    if (per_cu < 1) per_cu = 1;
    if (per_cu > 2) per_cu = 2;
    grid_blocks = cus * per_cu;
    if (ws_size < WS_TOTAL) fprintf(stderr, "kernel_launch: workspace too small: %zu < %zu\n", ws_size, (size_t)WS_TOTAL);
  }
  Params p{};
  const float** pp = (const float**)&p;
  for (int i = 0; i < 31; ++i) pp[i] = (const float*)d_in[i];
  p.out = (float*)d_out;
  p.ws = (unsigned char*)d_ws;
  p.ph_lo = 0;
  p.ph_hi = 12;
  (void)hipMemsetAsync((unsigned char*)d_ws + WS_BAR, 0, BAR_TOTAL_WORDS * 4, stream);
  void* args[] = {&p};
  hipError_t e = hipLaunchCooperativeKernel((void*)fwd_megakernel, dim3(grid_blocks), dim3(256), args, 0, stream);
  if (e != hipSuccess) fprintf(stderr, "cooperative launch failed: %s (grid %d)\n", hipGetErrorString(e), grid_blocks);
}
```
